# Optimizing an MI355X kernel written in HIP

```python
import functools
import jax, jax.numpy as jnp
from jax import lax
import numpy as np

D_MODEL = 1024
BATCH = 16
SEQ = 256
DEPTH = 2
DEC_BATCH = 8
DEC_SEQ = 4096
PAST_LEN = 512

GRID_W = 64
POOL_WIDTH = 256
POOL_GROUPS = 4
POOL_GROUP_DIM = POOL_WIDTH // POOL_GROUPS
POOL_WINDOWS = (2, 4, 8, 16)
NA_HEADS = 8
NA_HEAD_DIM = 64
NA_WIDTH = NA_HEADS * NA_HEAD_DIM
NA_WIN_ROWS = 8
NA_WIN_COLS = 16
GLA_WIDTH = D_MODEL - POOL_WIDTH - NA_WIDTH
GLA_HEADS = 4
GLA_DV = GLA_WIDTH // GLA_HEADS
GLA_DK = GLA_DV // 2
GLA_KEY_WIDTH = GLA_HEADS * GLA_DK
GLA_GATE_RANK = 16
GLA_GATE_TAU = 16.0
GLA_CHUNK = 64
ROPE_THETA = 10000.0
D_FF = -(-8 * D_MODEL // (3 * 256)) * 256
NORM_EPS = 1e-6
IN_SIZES = (POOL_WIDTH, NA_WIDTH, NA_WIDTH, NA_WIDTH, GLA_KEY_WIDTH, GLA_KEY_WIDTH, GLA_WIDTH, GLA_WIDTH, GLA_GATE_RANK, GLA_GATE_RANK)
IN_WIDTH = sum(IN_SIZES)
IN_SPLIT_POINTS = tuple(int(s) for s in np.cumsum(IN_SIZES)[:-1])

kernel_name = 'hybrid_pool_natten_gla_diffusion_step'


def rms_norm(x, gain):
    xf = x.astype(jnp.float32)
    y = xf * lax.rsqrt(jnp.mean(xf * xf, axis=-1, keepdims=True) + NORM_EPS)
    return (y * gain.astype(jnp.float32)).astype(x.dtype)


def axial_rope_tables(L):
    t = jnp.arange(L)
    row = (t // GRID_W).astype(jnp.float32)
    col = (t % GRID_W).astype(jnp.float32)
    half = GLA_DK // 2
    inv_freq = ROPE_THETA ** (-jnp.arange(0, half, 2, dtype=jnp.float32) / half)
    ang_r = (row[:, None] * inv_freq)[:, None, :]
    ang_c = (col[:, None] * inv_freq)[:, None, :]
    return (jnp.cos(ang_r), jnp.sin(ang_r), jnp.cos(ang_c), jnp.sin(ang_c))


def rope_rotate(x, cos, sin):
    n = x.shape[-1] // 2
    x1, x2 = x[..., :n], x[..., n:]
    return jnp.concatenate([x1 * cos - x2 * sin, x2 * cos + x1 * sin], axis=-1)


def apply_axial_rope(x, rope):
    cos_r, sin_r, cos_c, sin_c = rope
    half = x.shape[-1] // 2
    xf = x.astype(jnp.float32)
    out = jnp.concatenate([rope_rotate(xf[..., :half], cos_r, sin_r), rope_rotate(xf[..., half:], cos_c, sin_c)], axis=-1)
    return out.astype(x.dtype)


def pool_mixer(u, w_pool, pool_scale):
    B, L, _ = u.shape
    t = jnp.arange(L)
    uf = u.astype(jnp.float32)
    diffs = []
    for g, win in enumerate(POOL_WINDOWS):
        ug = uf[..., g * POOL_GROUP_DIM:(g + 1) * POOL_GROUP_DIM]
        csum = jnp.concatenate([jnp.zeros((B, 1, POOL_GROUP_DIM), jnp.float32), jnp.cumsum(ug, axis=1)], axis=1)
        lo = jnp.clip(t - win // 2, 0, L)
        hi = jnp.clip(t + win // 2, 0, L)
        mean = (csum[:, hi] - csum[:, lo]) / (hi - lo).astype(jnp.float32)[None, :, None]
        diffs.append(mean - ug)
    d = jnp.stack(diffs, axis=2).astype(u.dtype)
    y = jnp.einsum('blgc,gcd->blgd', d, w_pool).reshape(B, L, POOL_WIDTH)
    return y * pool_scale


def na_context_attn(q, k, v):
    B, L, H, dh = q.shape
    s = jnp.einsum('bqhd,bkhd->bhqk', q, k).astype(jnp.float32) * (dh ** -0.5)
    p = jax.nn.softmax(s, axis=-1).astype(v.dtype)
    return jnp.einsum('bhqk,bkhd->bqhd', p, v).reshape(B, L, H * dh)


def na_latent_attn(q, k, v, k_ctx, v_ctx, rel_bias):
    B, L, H, dh = q.shape
    R = L // GRID_W
    WR = min(NA_WIN_ROWS, R)
    WC = NA_WIN_COLS
    qg = q.reshape(B, R, GRID_W, H, dh)
    kg = k.reshape(B, R, GRID_W, H, dh)
    vg = v.reshape(B, R, GRID_W, H, dh)
    rows = jnp.arange(R)
    cols = jnp.arange(GRID_W)
    row_idx = jnp.clip(rows - WR // 2, 0, R - WR)[:, None] + jnp.arange(WR)
    col_idx = jnp.clip(cols - WC // 2, 0, GRID_W - WC)[:, None] + jnp.arange(WC)
    dr = row_idx - rows[:, None] + (NA_WIN_ROWS - 1)
    dc = col_idx - cols[:, None] + (NA_WIN_COLS - 1)
    bias = rel_bias[:, dr[:, None, :, None], dc[None, :, None, :]]
    bias = jnp.moveaxis(bias, 1, 0).astype(jnp.float32)
    scale = dh ** -0.5
    n_loc = WR * WC

    def row_block(args):
        q_r, ridx, b_r = args
        k_band = jnp.take(kg, ridx, axis=1)
        v_band = jnp.take(vg, ridx, axis=1)
        k_win = k_band[:, :, col_idx]
        v_win = v_band[:, :, col_idx]
        s_loc = jnp.einsum('bwhd,biwjhd->bhwij', q_r, k_win).astype(jnp.float32) * scale + b_r
        s_ctx = jnp.einsum('bwhd,bhnd->bhwn', q_r, k_ctx).astype(jnp.float32) * scale
        s = jnp.concatenate([s_loc.reshape(B, H, GRID_W, n_loc), s_ctx], axis=-1)
        p = jax.nn.softmax(s, axis=-1).astype(v.dtype)
        p_loc = p[..., :n_loc].reshape(B, H, GRID_W, WR, WC)
        p_ctx = p[..., n_loc:]
        return (jnp.einsum('bhwij,biwjhd->bwhd', p_loc, v_win)
                + jnp.einsum('bhwn,bhnd->bwhd', p_ctx, v_ctx))

    o = lax.map(row_block, (jnp.moveaxis(qg, 1, 0), row_idx, bias))
    return jnp.moveaxis(o, 0, 1).reshape(B, L, H * dh)


def gla_chunk_scan(q, k, v, log_a, s0):
    B, L, H, DK = q.shape
    DV = v.shape[-1]
    C = GLA_CHUNK
    N = L // C

    def to_chunks(a):
        return a.astype(jnp.float32).reshape(B, N, C, H, a.shape[-1]).transpose(1, 0, 3, 2, 4)

    mask = jnp.tril(jnp.ones((C, C), dtype=bool))[:, :, None]

    def step(S, inp):
        qc, kc, vc, gc = inp
        b = jnp.cumsum(gc, axis=2)
        o_inter = jnp.einsum('bhtd,bhde->bhte', qc * jnp.exp(b), S)
        decay = jnp.exp(jnp.where(mask, b[:, :, :, None, :] - b[:, :, None, :, :], -jnp.inf))
        attn = jnp.einsum('bhtd,bhsd,bhtsd->bhts', qc, kc, decay)
        o_intra = jnp.einsum('bhts,bhse->bhte', attn, vc)
        b_last = b[:, :, -1:, :]
        S = jnp.exp(b_last[:, :, 0, :])[..., None] * S + jnp.einsum('bhsd,bhse->bhde', kc * jnp.exp(b_last - b), vc)
        return S, o_inter + o_intra

    S, o = lax.scan(step, s0.astype(jnp.float32), (to_chunks(q), to_chunks(k), to_chunks(v), to_chunks(log_a)))
    o = o.transpose(1, 0, 3, 2, 4).reshape(B, L, H, DV)
    return o, S


def gla_mixer(q, k, v, g, lr_f, lr_b, w_gate_f, b_gate_f, w_gate_b, b_gate_b, norm_gain, s0_f, s0_b, rope):
    B, L, _ = q.shape
    q = q.reshape(B, L, GLA_HEADS, GLA_DK) * (GLA_DK ** -0.5)
    k = k.reshape(B, L, GLA_HEADS, GLA_DK)
    v = v.reshape(B, L, GLA_HEADS, GLA_DV)
    if rope is not None:
        q = apply_axial_rope(q, rope)
        k = apply_axial_rope(k, rope)
    la_f = (jax.nn.log_sigmoid((lr_f @ w_gate_f + b_gate_f).astype(jnp.float32)) / GLA_GATE_TAU).reshape(B, L, GLA_HEADS, GLA_DK)
    la_b = (jax.nn.log_sigmoid((lr_b @ w_gate_b + b_gate_b).astype(jnp.float32)) / GLA_GATE_TAU).reshape(B, L, GLA_HEADS, GLA_DK)
    flip = functools.partial(jnp.flip, axis=1)
    o_f, s_f = gla_chunk_scan(q, k, v, la_f, s0_f)
    o_b, s_b = gla_chunk_scan(flip(q), flip(k), flip(v), flip(la_b), s0_b)
    o = rms_norm(o_f + flip(o_b), norm_gain).astype(g.dtype)
    o = o * jax.nn.silu(g.reshape(B, L, GLA_HEADS, GLA_DV))
    return o.reshape(B, L, GLA_WIDTH), s_f, s_b


def swiglu(h, w_ffn_in, w_ffn_out):
    hg, hu = jnp.split(h @ w_ffn_in, 2, axis=-1)
    return (jax.nn.silu(hg) * hu) @ w_ffn_out


def trunk_layer(x, cond, lw, na_fn, s0_f, s0_b, rope):
    B, L, _ = x.shape
    mods = (jax.nn.silu(cond) @ lw['w_ada'] + lw['b_ada'])[:, None, :]
    shift1, scale1, gate1, shift2, scale2, gate2 = jnp.split(mods, 6, axis=-1)
    h = rms_norm(x, lw['norm1_gain']) * (1 + scale1) + shift1
    u_pool, q_na, k_na, v_na, q_la, k_la, v_la, g_la, lr_f, lr_b = jnp.split(h @ lw['w_in'], IN_SPLIT_POINTS, axis=-1)
    y_pool = pool_mixer(u_pool, lw['w_pool'], lw['pool_scale'])
    q_na = rms_norm(q_na.reshape(B, L, NA_HEADS, NA_HEAD_DIM), lw['q_norm_gain'])
    k_na = rms_norm(k_na.reshape(B, L, NA_HEADS, NA_HEAD_DIM), lw['k_norm_gain'])
    v_na = v_na.reshape(B, L, NA_HEADS, NA_HEAD_DIM)
    y_na = na_fn(q_na, k_na, v_na)
    y_la, s_f, s_b = gla_mixer(q_la, k_la, v_la, g_la, lr_f, lr_b, lw['w_gate_f'], lw['b_gate_f'],
                               lw['w_gate_b'], lw['b_gate_b'], lw['gla_norm_gain'], s0_f, s0_b, rope)
    x = x + gate1 * (jnp.concatenate([y_pool, y_na, y_la], axis=-1) @ lw['w_out'])
    h2 = rms_norm(x, lw['norm2_gain']) * (1 + scale2) + shift2
    x = x + gate2 * swiglu(h2, lw['w_ffn_in'], lw['w_ffn_out'])
    return x, k_na.transpose(0, 2, 1, 3), v_na.transpose(0, 2, 1, 3), s_f, s_b


def setup_inputs(seed: int = 0) -> dict:
    key = jax.random.key(seed)
    ks = jax.random.split(key, 26)
    D = D_MODEL

    def nrm(k, shape, s):
        return jax.random.normal(k, shape, jnp.float32) * s

    return {
        'x_prompt': nrm(ks[0], (BATCH, SEQ, D), 1.0),
        'x_sample': nrm(ks[1], (DEC_BATCH, DEC_SEQ, D), 1.0),
        'c': nrm(ks[2], (DEC_BATCH, D), 1.0),
        'cache_na_k': nrm(ks[3], (DEC_BATCH, DEPTH, NA_HEADS, PAST_LEN, NA_HEAD_DIM), 1.0),
        'cache_na_v': nrm(ks[4], (DEC_BATCH, DEPTH, NA_HEADS, PAST_LEN, NA_HEAD_DIM), 1.0),
        'state_gla_fwd': nrm(ks[5], (DEC_BATCH, DEPTH, GLA_HEADS, GLA_DK, GLA_DV), 2.0),
        'state_gla_bwd': nrm(ks[6], (DEC_BATCH, DEPTH, GLA_HEADS, GLA_DK, GLA_DV), 2.0),
        'c_ctx': nrm(ks[7], (D,), 1.0),
        'w_ada': nrm(ks[8], (DEPTH, D, 6 * D), 0.5 * D ** -0.5),
        'b_ada': nrm(ks[9], (DEPTH, 6 * D), 0.02),
        'norm1_gain': 1.0 + nrm(ks[10], (DEPTH, D), 0.02),
        'norm2_gain': 1.0 + nrm(ks[11], (DEPTH, D), 0.02),
        'w_in': nrm(ks[12], (DEPTH, D, IN_WIDTH), D ** -0.5),
        'w_pool': nrm(ks[13], (DEPTH, POOL_GROUPS, POOL_GROUP_DIM, POOL_GROUP_DIM), POOL_GROUP_DIM ** -0.5),
        'pool_scale': 1.0 + nrm(ks[14], (DEPTH, POOL_WIDTH), 0.1),
        'q_norm_gain': 1.0 + nrm(ks[15], (DEPTH, NA_HEAD_DIM), 0.02),
        'k_norm_gain': 1.0 + nrm(ks[16], (DEPTH, NA_HEAD_DIM), 0.02),
        'rel_bias': nrm(ks[17], (DEPTH, NA_HEADS, 2 * NA_WIN_ROWS - 1, 2 * NA_WIN_COLS - 1), 0.5),
        'w_gate_f': nrm(ks[18], (DEPTH, GLA_GATE_RANK, GLA_KEY_WIDTH), GLA_GATE_RANK ** -0.5),
        'b_gate_f': nrm(ks[19], (DEPTH, GLA_KEY_WIDTH), 0.1),
        'w_gate_b': nrm(ks[20], (DEPTH, GLA_GATE_RANK, GLA_KEY_WIDTH), GLA_GATE_RANK ** -0.5),
        'b_gate_b': nrm(ks[21], (DEPTH, GLA_KEY_WIDTH), 0.1),
        'gla_norm_gain': 1.0 + nrm(ks[22], (DEPTH, GLA_DV), 0.02),
        'w_out': nrm(ks[23], (DEPTH, D, D), D ** -0.5),
        'w_ffn_in': nrm(ks[24], (DEPTH, D, 2 * D_FF), D ** -0.5),
        'w_ffn_out': nrm(ks[25], (DEPTH, D_FF, D), D_FF ** -0.5),
    }


def reference(x_prompt, x_sample, c, cache_na_k, cache_na_v, state_gla_fwd, state_gla_bwd, c_ctx,
              w_ada, b_ada, norm1_gain, norm2_gain, w_in, w_pool, pool_scale, q_norm_gain, k_norm_gain,
              rel_bias, w_gate_f, b_gate_f, w_gate_b, b_gate_b, gla_norm_gain, w_out, w_ffn_in, w_ffn_out):
    def layer_weights(l):
        return {'w_ada': w_ada[l], 'b_ada': b_ada[l], 'norm1_gain': norm1_gain[l], 'norm2_gain': norm2_gain[l],
                'w_in': w_in[l], 'w_pool': w_pool[l], 'pool_scale': pool_scale[l],
                'q_norm_gain': q_norm_gain[l], 'k_norm_gain': k_norm_gain[l],
                'w_gate_f': w_gate_f[l], 'b_gate_f': b_gate_f[l], 'w_gate_b': w_gate_b[l], 'b_gate_b': b_gate_b[l],
                'gla_norm_gain': gla_norm_gain[l], 'w_out': w_out[l],
                'w_ffn_in': w_ffn_in[l], 'w_ffn_out': w_ffn_out[l]}

    xp = x_prompt
    zero_state = jnp.zeros((xp.shape[0], GLA_HEADS, GLA_DK, GLA_DV), jnp.float32)
    ks, vs, sfs, sbs = [], [], [], []
    for l in range(DEPTH):
        xp, k_l, v_l, sf_l, sb_l = trunk_layer(xp, c_ctx[None, :], layer_weights(l), na_context_attn,
                                               zero_state, zero_state, None)
        ks.append(k_l)
        vs.append(v_l)
        sfs.append(sf_l)
        sbs.append(sb_l)
    new_na_k = jnp.stack(ks, axis=1)
    new_na_v = jnp.stack(vs, axis=1)
    new_gla_fwd = jnp.stack(sfs, axis=1)
    new_gla_bwd = jnp.stack(sbs, axis=1)

    xs = x_sample
    rope = axial_rope_tables(xs.shape[1])
    for l in range(DEPTH):
        na_fn = functools.partial(na_latent_attn, k_ctx=cache_na_k[:, l], v_ctx=cache_na_v[:, l], rel_bias=rel_bias[l])
        xs = trunk_layer(xs, c, layer_weights(l), na_fn, state_gla_fwd[:, l], state_gla_bwd[:, l], rope)[0]

    return (xp, xs, new_na_k, new_na_v, new_gla_fwd, new_gla_bwd)
```

```cpp
#include <hip/hip_runtime.h>
#include <cstdio>
#include <cstdint>
#include <type_traits>

#ifndef REPEAT_MASK
#define REPEAT_MASK 0
#endif
#ifndef REPEAT_EPI
#define REPEAT_EPI 0
#endif
#ifndef MK_ONE_LAUNCH
#define MK_ONE_LAUNCH 1
#endif

#define LAS __attribute__((address_space(3)))
#define GAS __attribute__((address_space(1)))
#define CAS __attribute__((address_space(4)))
typedef unsigned short bf16;
typedef short bf16x8 __attribute__((ext_vector_type(8)));
typedef float f32x4 __attribute__((ext_vector_type(4)));
typedef float f32x2 __attribute__((ext_vector_type(2)));
typedef unsigned u32x4 __attribute__((ext_vector_type(4)));
typedef unsigned u32x2 __attribute__((ext_vector_type(2)));

constexpr int DM = 1024, DEPTH = 2, NCOND = 9;
constexpr int M_CTX = 4096, M_LAT = 32768, M = 36864;
constexpr int IN_W = 2592, IN_WP = 2816, DFF = 2816, FF2 = 5632;
constexpr int NCHUNK = M / 64;
constexpr float EPS = 1e-6f;
constexpr size_t OUT_YP = 0, OUT_YS = (size_t)M_CTX * DM, OUT_K = (size_t)M * DM, OUT_V = OUT_K + 4194304, OUT_GF = OUT_V + 4194304, OUT_GB = OUT_GF + 262144;
constexpr float LOG2E = 1.4426950408889634f;
constexpr float QSCALE = 0.125f * LOG2E;

constexpr size_t MiB = 1u << 20;
constexpr size_t WS_CTL = 0;
constexpr size_t WS_ROWSS = 1 * MiB;
constexpr size_t WS_CVA = 2 * MiB;
constexpr size_t ZERO_BYTES = 3 * MiB;
constexpr size_t WS_CVD = 3 * MiB;
constexpr size_t WS_MODS = 4 * MiB;
constexpr size_t WS_WSC = 5 * MiB;
constexpr size_t WS_ROPE = 5 * MiB + 512 * 1024;
constexpr size_t WS_WIN = 6 * MiB;
constexpr size_t WS_WOUT = 18 * MiB;
constexpr size_t WS_WFFI = 22 * MiB;
constexpr size_t WS_WFFO = 44 * MiB;
constexpr size_t WS_XA = 56 * MiB;
constexpr size_t WS_Y = 128 * MiB;
constexpr size_t WS_P = 200 * MiB;
constexpr size_t WS_U = WS_P;
constexpr size_t WS_Q = WS_P + 18 * MiB;
constexpr size_t WS_K = WS_P + 54 * MiB;
constexpr size_t WS_V = WS_P + 90 * MiB;
constexpr size_t WS_QLK = WS_P + 126 * MiB;
constexpr size_t WS_VL = WS_P + 144 * MiB;
constexpr size_t WS_GS = WS_P + 162 * MiB;
constexpr size_t WS_LR = WS_P + 180 * MiB;
constexpr size_t WS_H = 128 * MiB;
constexpr size_t WS_XR = 326 * MiB;
constexpr size_t WS_UF = 386 * MiB;
constexpr size_t WS_UB = 404 * MiB;
constexpr size_t WS_DF = 422 * MiB;
constexpr size_t WS_DB = 423 * MiB;
constexpr size_t WS_CK = 424 * MiB;
constexpr size_t WS_CV = 432 * MiB;
constexpr size_t WS_QKT = 440 * MiB;
constexpr size_t WS_SINF = 440 * MiB;
constexpr size_t WS_SINB = 458 * MiB;
constexpr size_t WS_STF = 476 * MiB;
constexpr size_t WS_STB = 485 * MiB;
constexpr size_t WS_WPT = 494 * MiB;
constexpr size_t WS_END = 495 * MiB;
static_assert(WS_LR + (size_t)M * 32 * 4 <= WS_UF && WS_H + (size_t)M * DFF * 2 <= WS_XR && WS_XR + (size_t)M * DM * 2 <= WS_DF && WS_END <= 512 * MiB, "ws map");

constexpr int CW_BAR = 4096;

typedef __bf16 bf16x2n __attribute__((ext_vector_type(2)));
__device__ __forceinline__ unsigned cvt_pk_bf16(float lo, float hi) { const f32x2 v = {lo, hi}; return __builtin_bit_cast(unsigned, __builtin_convertvector(v, bf16x2n)); }
__device__ __forceinline__ float bf2f(bf16 b) { return __uint_as_float((unsigned)b << 16); }
__device__ __forceinline__ float bflo(unsigned w) { return __uint_as_float(w << 16); }
__device__ __forceinline__ float bfhi(unsigned w) { return __uint_as_float(w & 0xffff0000u); }
__device__ __forceinline__ float siluf(float x) { return x * __builtin_amdgcn_rcpf(1.0f + __builtin_amdgcn_exp2f(x * -1.4426950408889634f)); }
template <int CTRL> __device__ __forceinline__ float dpp0(float x) { return __int_as_float(__builtin_amdgcn_update_dpp(0, __float_as_int(x), CTRL, 0xf, 0xf, true)); }
__device__ __forceinline__ float rdlane(float x, int l) { return __int_as_float(__builtin_amdgcn_readlane(__float_as_int(x), l)); }
__device__ __forceinline__ float wave_sum(float v) {
#pragma unroll
    for (int o = 1; o < 64; o <<= 1) v += __shfl_xor(v, o);
    return v;
}
__device__ __forceinline__ u32x4 pack8(const f32x4 a, const f32x4 b) {
    u32x4 w; w.x = cvt_pk_bf16(a[0], a[1]); w.y = cvt_pk_bf16(a[2], a[3]); w.z = cvt_pk_bf16(b[0], b[1]); w.w = cvt_pk_bf16(b[2], b[3]); return w;
}

namespace pg8 {
constexpr int BM = 256, BK = 64, HALF = 128, HTB = HALF * BK * 2, STAGE_BYTES = 8 * HTB, NXCD = 8, WGM = 8;
__host__ __device__ __forceinline__ int lds_byte(int r, int c) { const int st = (r >> 4) * 2 + (c >> 5), rr = r & 15, cc = c & 31, ob = rr * 64 + cc * 2; return st * 1024 + (ob ^ (((ob >> 9) & 1) << 5)); }
__host__ __device__ __forceinline__ void stage_rc(int b, int& R, int& C) { const int st = b / 1024, sb = b % 1024, swz = sb ^ (((sb >> 9) & 1) << 5); R = (st >> 1) * 16 + swz / 64; C = (st & 1) * 32 + (swz % 64) / 2; }
struct Unit { int pm, pn, rsh; };
struct Gemm { const bf16* A; const bf16* Bt; int M, N, K; };
struct StaticOrder {
    int nM, nN, nwg, G, c, lim;
    __host__ __device__ __forceinline__ void init(int M_, int N_, int G_, int c_, int S_ = 0) { nM = M_ / BM; nN = N_ / BM; nwg = nM * nN; G = G_; c = c_; lim = nwg;
        const int Lf = nwg % G; if (S_ > 0 && Lf > 0 && (G % NXCD) == 0 && (Lf % NXCD) == 0 && Lf * 4 <= S_ * G) lim = nwg - Lf; }
    __host__ __device__ __forceinline__ void unit_of(int L, Unit& u) const {
        int wgid = L; { const int q = nwg / NXCD, r = nwg % NXCD, xcd = wgid % NXCD, off = wgid / NXCD; wgid = (xcd < r ? xcd * (q + 1) : r * (q + 1) + (xcd - r) * q) + off; }
        const int nig = WGM * nN, gid = wgid / nig, fm = gid * WGM, gsz = (nM - fm) < WGM ? (nM - fm) : WGM;
        u.pm = fm + ((wgid % nig) % gsz); u.pn = (wgid % nig) / gsz; u.rsh = 0;
    }
    __host__ __device__ __forceinline__ bool next(int i, Unit& u) const {
        const long L = (long)i * G + c; if (L >= lim) return false;
        unit_of((int)L, u); return true;
    }
    __host__ __device__ __forceinline__ bool sub4(int k, Unit& u) const {
        if (lim == nwg) return false;
        const int x = c % NXCD, j = c / NXCD + k * (G / NXCD), Lf = nwg - lim; if (j >= 4 * (Lf / NXCD)) return false;
        unit_of(lim + (j >> 2) * NXCD + x, u); const int q = j & 3; u.rsh = 128 * (q >> 1) + 32 * (q & 1); return true;
    }
};
template <class Epi, class Sched>
__device__ __forceinline__ void gemm_phase(LAS unsigned char* lds, const Gemm g, const Sched& S, const Epi& E, const int tid) {
    const int wid = __builtin_amdgcn_readfirstlane(tid >> 6), lane = tid & 63, wr = wid >> 2, wc = wid & 3, fr = lane & 15, fq = lane >> 4;
    const int K = g.K, nt = K / BK;
    unsigned voffA[2];
#pragma unroll
    for (int i = 0; i < 2; ++i) { int R, C; stage_rc(tid * 16 + i * 8192, R, C); voffA[i] = (unsigned)(R * K + C) * 2u; }
    const size_t kstep = (size_t)(BK * 2);
    const size_t hstep = (size_t)HALF * K * 2;
    const size_t tstep = 2 * hstep;
    const unsigned ldsw = (unsigned)wid * 1024u;
    const int aoff = lds_byte(wr * 64 + fr, fq * 8), boff = lds_byte(wc * 32 + fr, fq * 8);
#define PG8_SA(b, h) (((b) * 2 + (h)) * HTB)
#define PG8_SB(b, h) ((4 + (b) * 2 + (h)) * HTB)
#define PG8_STAGE(bufoff, gbase) do { _Pragma("unroll") for (int _i = 0; _i < 2; ++_i) \
        __builtin_amdgcn_global_load_lds((const unsigned*)((const char*)(gbase) + voffA[_i]), (LAS unsigned*)(lds + (bufoff) + ldsw + _i * 8192), 16, 0, 0); } while (0)
#define PG8_LDA(dst, b, h) do { _Pragma("unroll") for (int m = 0; m < 4; ++m) _Pragma("unroll") for (int k = 0; k < 2; ++k) dst[m][k] = *(const LAS bf16x8*)(lds + PG8_SA(b, h) + aoff + m * 2048 + k * 1024); } while (0)
#define PG8_LDB(dst, b, h) do { _Pragma("unroll") for (int n = 0; n < 2; ++n) _Pragma("unroll") for (int k = 0; k < 2; ++k) dst[n][k] = *(const LAS bf16x8*)(lds + PG8_SB(b, h) + boff + n * 2048 + k * 1024); } while (0)
#define PG8_MMA(ai, bj, At, Bt) do { __builtin_amdgcn_s_setprio(1); _Pragma("unroll") for (int m = 0; m < 4; ++m) _Pragma("unroll") for (int n = 0; n < 2; ++n) _Pragma("unroll") for (int k = 0; k < 2; ++k) \
        acc[ai][bj][m][n] = __builtin_amdgcn_mfma_f32_16x16x32_bf16(Bt[n][k], At[m][k], acc[ai][bj][m][n], 0, 0, 0); __builtin_amdgcn_s_setprio(0); } while (0)
#define PG8_WAIT_V(n) asm volatile("s_waitcnt vmcnt(" #n ")" ::: "memory")
#define PG8_WAIT_L(n) asm volatile("s_waitcnt lgkmcnt(" #n ")" ::: "memory")
#define PG8_BAR __builtin_amdgcn_s_barrier()
#define PG8_SCHED __builtin_amdgcn_sched_barrier(0)
    Unit cur, nxt; int ui = 0;
    if (!S.next(0, cur)) return;
    constexpr int PF_OFF = 131072 + 4096;
    if constexpr (Epi::PREF) E.pref(lds + PF_OFF, cur, wid, lane);
    f32x4 acc[2][2][4][2];
#pragma unroll
    for (int a = 0; a < 2; ++a)
#pragma unroll
        for (int b = 0; b < 2; ++b)
#pragma unroll
            for (int m = 0; m < 4; ++m)
#pragma unroll
                for (int n = 0; n < 2; ++n) acc[a][b][m][n] = (f32x4){0.f, 0.f, 0.f, 0.f};
    bf16x8 At[4][2], B0[2][2], B1[2][2];
    const char* cA = (const char*)g.A + (size_t)cur.pm * tstep; const char* cB = (const char*)g.Bt + (size_t)cur.pn * tstep;
    PG8_STAGE(PG8_SB(0, 0), cB); PG8_STAGE(PG8_SB(0, 1), cB + hstep); PG8_STAGE(PG8_SA(0, 0), cA); PG8_STAGE(PG8_SA(0, 1), cA + hstep);
    if (wr == 1) PG8_BAR;
    PG8_WAIT_V(2); PG8_BAR;
    PG8_STAGE(PG8_SB(1, 0), cB + kstep); PG8_STAGE(PG8_SA(1, 0), cA + kstep); PG8_STAGE(PG8_SB(1, 1), cB + hstep + kstep);
    PG8_WAIT_V(6); PG8_BAR;
    for (;;) {
        const bool has_next = S.next(ui + 1, nxt);
        const char* nA = has_next ? (const char*)g.A + (size_t)nxt.pm * tstep : cA; const char* nB = has_next ? (const char*)g.Bt + (size_t)nxt.pn * tstep : cB;
        for (int t = 0; t < nt; t += 2) {
            const bool last = (t == nt - 2);
            const char* a1 = cA + (size_t)(t + 1) * kstep;
            const char* a2 = last ? nA : cA + (size_t)(t + 2) * kstep; const char* b2 = last ? nB : cB + (size_t)(t + 2) * kstep;
            const char* a3 = a2 + kstep; const char* b3 = b2 + kstep;
            PG8_LDB(B0, 0, 0); PG8_LDB(B1, 0, 1); PG8_SCHED; PG8_LDA(At, 0, 0); PG8_STAGE(PG8_SA(1, 1), a1 + hstep);
            PG8_WAIT_V(8); PG8_WAIT_L(0); PG8_BAR; PG8_MMA(0, 0, At, B0); PG8_MMA(0, 1, At, B1); PG8_BAR; PG8_SCHED;
            PG8_LDA(At, 0, 1); PG8_STAGE(PG8_SB(0, 0), b2); PG8_STAGE(PG8_SB(0, 1), b2 + hstep); PG8_STAGE(PG8_SA(0, 0), a2);
            PG8_WAIT_V(8); PG8_WAIT_L(0); PG8_BAR; PG8_MMA(1, 0, At, B0); PG8_MMA(1, 1, At, B1); PG8_BAR; PG8_SCHED;
            PG8_LDB(B0, 1, 0); PG8_LDB(B1, 1, 1); PG8_SCHED; PG8_LDA(At, 1, 0); PG8_STAGE(PG8_SA(0, 1), a2 + hstep);
            PG8_WAIT_V(8); PG8_WAIT_L(0); PG8_BAR; PG8_MMA(0, 0, At, B0); PG8_MMA(0, 1, At, B1); PG8_BAR; PG8_SCHED;
            PG8_LDA(At, 1, 1); PG8_STAGE(PG8_SB(1, 0), b3); PG8_STAGE(PG8_SB(1, 1), b3 + hstep); PG8_STAGE(PG8_SA(1, 0), a3);
            PG8_WAIT_V(8); PG8_WAIT_L(0); PG8_BAR; PG8_MMA(1, 0, At, B0); PG8_MMA(1, 1, At, B1); PG8_BAR; PG8_SCHED;
        }
        if (wr == 0) PG8_BAR;
        if constexpr (Epi::PREF) { if (has_next) E.pref(lds + PF_OFF + ((ui + 1) & 1) * 2048, nxt, wid, lane); }
        E.template run<2, 4, Epi::PREF>(acc, cur, wr, wc, fr, fq, (const LAS float*)(lds + PF_OFF + (ui & 1) * 2048));
        if constexpr (REPEAT_EPI && Epi::IDEMPOTENT) { asm volatile("" ::: "memory"); E.template run<2, 4, Epi::PREF>(acc, cur, wr, wc, fr, fq, (const LAS float*)(lds + PF_OFF + (ui & 1) * 2048)); }
        if (!has_next) break;
#pragma unroll
        for (int a = 0; a < 2; ++a)
#pragma unroll
            for (int b = 0; b < 2; ++b)
#pragma unroll
                for (int m = 0; m < 4; ++m)
#pragma unroll
                    for (int n = 0; n < 2; ++n) acc[a][b][m][n] = (f32x4){0.f, 0.f, 0.f, 0.f};
        cur = nxt; cA = nA; cB = nB; ++ui;
        if (wr == 1) PG8_BAR;
    }
    PG8_WAIT_V(0);
    PG8_BAR;
#undef PG8_SA
#undef PG8_SB
#undef PG8_STAGE
#undef PG8_LDA
#undef PG8_LDB
#undef PG8_MMA
}
constexpr int SUB_STB = 2 * HTB + 8192;
template <class Epi>
__device__ __forceinline__ void gemm_sub4(LAS unsigned char* lds, const Gemm g, const Unit cur, const Epi& E, const int tid) {
    const int wid = __builtin_amdgcn_readfirstlane(tid >> 6), lane = tid & 63, wr = wid >> 2, wc = wid & 3, fr = lane & 15, fq = lane >> 4;
    const int K = g.K, nt = K / BK;
    unsigned voffB[2], voffQ;
#pragma unroll
    for (int i = 0; i < 2; ++i) { int R, C; stage_rc(tid * 16 + i * 8192, R, C); voffB[i] = (unsigned)(R * K + C) * 2u; }
    { int R, C; stage_rc(tid * 16, R, C); voffQ = (unsigned)((64 * (R >> 5) + (R & 31)) * K + C) * 2u; }
    const size_t kstep = (size_t)(BK * 2);
    const size_t hstep = (size_t)HALF * K * 2;
    const size_t tstep = 2 * hstep;
    const unsigned ldsw = (unsigned)wid * 1024u;
    const int aoff = 2 * HTB + lds_byte(wr * 32 + fr, fq * 8), boff = lds_byte(wc * 32 + fr, fq * 8);
    const char* cA = (const char*)g.A + (size_t)cur.pm * tstep + (size_t)cur.rsh * K * 2; const char* cB = (const char*)g.Bt + (size_t)cur.pn * tstep;
#define SUB_STAGE(so, tile) do { const char* b_ = cB + (size_t)(tile) * kstep; const char* a_ = cA + (size_t)(tile) * kstep; \
        _Pragma("unroll") for (int _h = 0; _h < 2; ++_h) _Pragma("unroll") for (int _i = 0; _i < 2; ++_i) \
            __builtin_amdgcn_global_load_lds((const unsigned*)(b_ + _h * hstep + voffB[_i]), (LAS unsigned*)(lds + (so) + _h * HTB + ldsw + _i * 8192), 16, 0, 0); \
        __builtin_amdgcn_global_load_lds((const unsigned*)(a_ + voffQ), (LAS unsigned*)(lds + (so) + 2 * HTB + ldsw), 16, 0, 0); } while (0)
#define SUB_LD(Aq, Bq0, Bq1, so) do { _Pragma("unroll") for (int n = 0; n < 2; ++n) _Pragma("unroll") for (int k = 0; k < 2; ++k) { \
            Bq0[n][k] = *(const LAS bf16x8*)(lds + (so) + boff + n * 2048 + k * 1024); Bq1[n][k] = *(const LAS bf16x8*)(lds + (so) + HTB + boff + n * 2048 + k * 1024); } \
        _Pragma("unroll") for (int m = 0; m < 2; ++m) _Pragma("unroll") for (int k = 0; k < 2; ++k) Aq[m][k] = *(const LAS bf16x8*)(lds + (so) + aoff + m * 2048 + k * 1024); } while (0)
#define SUB_MMA(Aq, Bq0, Bq1) do { __builtin_amdgcn_s_setprio(1); _Pragma("unroll") for (int m = 0; m < 2; ++m) _Pragma("unroll") for (int n = 0; n < 2; ++n) _Pragma("unroll") for (int k = 0; k < 2; ++k) { \
            acc[0][0][m][n] = __builtin_amdgcn_mfma_f32_16x16x32_bf16(Bq0[n][k], Aq[m][k], acc[0][0][m][n], 0, 0, 0); \
            acc[0][1][m][n] = __builtin_amdgcn_mfma_f32_16x16x32_bf16(Bq1[n][k], Aq[m][k], acc[0][1][m][n], 0, 0, 0); } __builtin_amdgcn_s_setprio(0); } while (0)
    f32x4 acc[2][2][4][2];
#pragma unroll
    for (int b = 0; b < 2; ++b)
#pragma unroll
        for (int m = 0; m < 2; ++m)
#pragma unroll
            for (int n = 0; n < 2; ++n) acc[0][b][m][n] = (f32x4){0.f, 0.f, 0.f, 0.f};
    bf16x8 A0[2][2], A1[2][2], B00[2][2], B01[2][2], B10[2][2], B11[2][2];
    SUB_STAGE(0, 0); SUB_STAGE(SUB_STB, 1); SUB_STAGE(2 * SUB_STB, 2);
    PG8_WAIT_V(10); PG8_BAR;
    SUB_LD(A0, B00, B01, 0);
    PG8_WAIT_V(5); PG8_WAIT_L(0); PG8_BAR;
    int so = 0;
    for (int t = 0; t < nt; t += 2) {
        {   const int so1 = (so == 2 * SUB_STB) ? 0 : so + SUB_STB; const bool st3 = t + 3 < nt;
            if (st3) SUB_STAGE(so, t + 3);
            SUB_LD(A1, B10, B11, so1); PG8_SCHED;
            SUB_MMA(A0, B00, B01);
            if (st3) PG8_WAIT_V(5); else PG8_WAIT_V(0);
            PG8_WAIT_L(0); PG8_BAR; so = so1; }
        {   const int so1 = (so == 2 * SUB_STB) ? 0 : so + SUB_STB; const bool st3 = t + 4 < nt, rd = t + 2 < nt;
            if (st3) SUB_STAGE(so, t + 4);
            if (rd) SUB_LD(A0, B00, B01, so1);
            PG8_SCHED;
            SUB_MMA(A1, B10, B11);
            if (st3) PG8_WAIT_V(5); else PG8_WAIT_V(0);
            PG8_WAIT_L(0); PG8_BAR; so = so1; }
    }
    E.template run<1, 2, false>(acc, cur, wr, wc, fr, fq, nullptr);
#undef SUB_STAGE
#undef SUB_LD
#undef SUB_MMA
#undef PG8_WAIT_V
#undef PG8_WAIT_L
#undef PG8_BAR
#undef PG8_SCHED
}
}

__device__ __forceinline__ int lgroup(int kind, int p0) {
    const int pn = p0 >> 8, pg = (p0 >> 5) & 7;
    if (kind == 0) { const int l = 256 * pn + 32 * (((pg & 3) << 1) | (pg >> 2)); return l < IN_W ? l : -1; }
    if (kind == 2) return (pg >> 2) * DFF + 128 * pn + 32 * (pg & 3);
    return p0;
}
__device__ __forceinline__ int llow5(bool rope, int p) {
    return rope ? ((((p >> 3) & 1) << 4) | (((p >> 4) & 1) << 3) | (((p >> 2) & 1) << 2) | (p & 3))
                : ((((p >> 2) & 3) << 3) | (((p >> 4) & 1) << 2) | (p & 3));
}
__device__ __forceinline__ int plow(bool rope, int l) {
    return rope ? ((((l >> 3) & 1) << 4) | (((l >> 4) & 1) << 3) | (((l >> 2) & 1) << 2) | (l & 3))
                : ((((l >> 2) & 1) << 4) | (((l >> 3) & 3) << 2) | (l & 3));
}

typedef const f32x4 (&AccRef)[2][2][4][2];
__device__ __forceinline__ int cond_of_pm(int pm) { return pm < 16 ? 8 : ((pm - 16) >> 4); }
#define EPI_FENCE() asm volatile("" ::: "memory")
template <class T> __device__ __forceinline__ T* wsptr(unsigned char* ws, size_t off) { return (T*)(ws + off); }

struct EpiA {
    static constexpr bool IDEMPOTENT = true, PREF = true;
    int layer; unsigned char* ws; float* out; const float* qg; const float* kg;
    __device__ __forceinline__ void pref(LAS unsigned char* dst, const pg8::Unit& u, int wid, int lane) const {
        if (wid < 2) {
            GAS unsigned char* wg_ = (GAS unsigned char*)ws; asm volatile("" : "+s"(wg_)); unsigned char* w = (unsigned char*)wg_;
            const float* src;
            if (wid == 0) src = wsptr<float>(w, WS_ROWSS) + (size_t)(2 * layer) * M + u.pm * 256 + lane * 4;
            else src = wsptr<float>(w, WS_CVA) + ((size_t)layer * NCOND + cond_of_pm(u.pm)) * IN_WP + u.pn * 256 + lane * 4;
            __builtin_amdgcn_global_load_lds((const unsigned*)src, (LAS unsigned*)(dst + wid * 1024), 16, 0, 0);
        }
    }
    template <int NAI, int NM, bool PF> __device__ __forceinline__ void run(AccRef acc, const pg8::Unit& u, int wr, int wc, int fr_, int fq_, const LAS float* Pf) const {
        GAS unsigned char* wg_ = (GAS unsigned char*)ws; int fr = fr_, fq = fq_; asm volatile("" : "+s"(wg_), "+v"(fr), "+v"(fq)); unsigned char* w = (unsigned char*)wg_;
        const int pn = u.pn, pm = u.pm, ci = cond_of_pm(pm);
        const float* rowss = wsptr<float>(w, WS_ROWSS) + (size_t)(2 * layer) * M;
        const bool isrope = (pn == 7);
        int off[2];
#pragma unroll
        for (int n = 0; n < 2; ++n) off[n] = isrope ? (16 * (fq >> 1) + 8 * n + 4 * (fq & 1)) : (8 * fq + 4 * n);
        const float* cv = wsptr<float>(w, WS_CVA) + ((size_t)layer * NCOND + ci) * IN_WP + pn * 256 + wc * 64;
#define EPIA_CVV f32x4 cvv[2][2]; _Pragma("unroll") for (int bj = 0; bj < 2; ++bj) _Pragma("unroll") for (int n = 0; n < 2; ++n) { \
            if constexpr (PF) cvv[bj][n] = *(const LAS f32x4*)(Pf + 256 + wc * 64 + 32 * bj + off[n]); else cvv[bj][n] = *(const f32x4*)(cv + 32 * bj + off[n]); }
        const int rbase = pm * 256 + u.rsh + wr * 64 + fr;
#define EPIA_RS(ai) float rsv[NM]; _Pragma("unroll") for (int j = 0; j < NM; ++j) { if constexpr (PF) rsv[j] = Pf[wr * 64 + fr + (ai) * 128 + j * 16]; else rsv[j] = rowss[rbase + (ai) * 128 + j * 16]; } \
        _Pragma("unroll") for (int j = 0; j < NM; ++j) rsv[j] = rsqrtf(rsv[j] * (1.0f / DM) + EPS);
#define EPIA_X(ai, m) const int r = rbase + (ai) * 128 + (m) * 16; const float rs = rsv[(m)]; f32x4 x[2][2]; \
        _Pragma("unroll") for (int bj = 0; bj < 2; ++bj) _Pragma("unroll") for (int n = 0; n < 2; ++n) x[bj][n] = acc[ai][bj][m][n] * rs + cvv[bj][n];
#define EPIA_LOOP _Pragma("unroll") for (int ai = 0; ai < NAI; ++ai) { EPIA_RS(ai) _Pragma("unroll") for (int m = 0; m < NM; ++m)
        if (pn == 0 || pn == 8) {
            bf16* dst = wsptr<bf16>(w, pn == 0 ? WS_U : WS_VL); EPIA_CVV
            EPIA_LOOP { EPIA_X(ai, m)
#pragma unroll
                for (int bj = 0; bj < 2; ++bj) *(u32x4*)(dst + (size_t)r * 256 + wc * 64 + 32 * bj + 8 * fq) = pack8(x[bj][0], x[bj][1]);
                EPI_FENCE(); } }
        } else if (pn <= 6) {
            const int which = (pn - 1) >> 1, hh = ((pn - 1) & 1) * 4 + wc; EPIA_CVV
            const float* gp = ((which == 0) ? qg : kg) + 8 * fq;
            bf16* dst = wsptr<bf16>(w, which == 0 ? WS_Q : (which == 1 ? WS_K : WS_V));
            float* ob = out + (which == 1 ? OUT_K : OUT_V) + ((size_t)((pm * 2 + layer) * 8 + hh) * 256) * 64;
            EPIA_LOOP { EPIA_X(ai, m)
                if (which < 2) {
                    float ss = 0.f;
#pragma unroll
                    for (int bj = 0; bj < 2; ++bj)
#pragma unroll
                        for (int n = 0; n < 2; ++n) { const f32x4 v = x[bj][n]; ss += (v[0] * v[0] + v[1] * v[1]) + (v[2] * v[2] + v[3] * v[3]); }
                    ss += __shfl_xor(ss, 16); ss += __shfl_xor(ss, 32);
                    float rn = rsqrtf(ss * (1.0f / 64.0f) + EPS); if (which == 0) rn *= QSCALE;
#pragma unroll
                    for (int bj = 0; bj < 2; ++bj)
#pragma unroll
                        for (int n = 0; n < 2; ++n) x[bj][n] = x[bj][n] * rn * *(const f32x4*)(gp + 32 * bj + 4 * n);
                }
#pragma unroll
                for (int bj = 0; bj < 2; ++bj) *(u32x4*)(dst + (size_t)r * 512 + hh * 64 + 32 * bj + 8 * fq) = pack8(x[bj][0], x[bj][1]);
                if (which >= 1 && pm < 16) {
                    float* o = ob + (size_t)(r - pm * 256) * 64;
#pragma unroll
                    for (int bj = 0; bj < 2; ++bj)
#pragma unroll
                        for (int n = 0; n < 2; ++n) *(f32x4*)(o + 32 * bj + 8 * fq + 4 * n) = x[bj][n];
                }
                EPI_FENCE(); } }
        } else if (pn == 7) {
            const bool isq = wc < 2;
            bf16* QLK = wsptr<bf16>(w, WS_QLK); const float* rope = wsptr<float>(w, WS_ROPE); EPIA_CVV
            EPIA_LOOP { EPIA_X(ai, m)
                const int t = (r - M_CTX) & 4095;
                const int pos = (fq >> 1) ? (t & 63) : (t >> 6);
                f32x4 cs = (f32x4){1.f, 1.f, 1.f, 1.f}, sn = (f32x4){0.f, 0.f, 0.f, 0.f};
                if (pm >= 16) {
                    const f32x4* rp = (const f32x4*)(rope + (size_t)pos * 16 + 8 * (fq & 1));
                    const f32x4 c01 = rp[0], c23 = rp[1];
                    cs = (f32x4){c01[0], c01[2], c23[0], c23[2]}; sn = (f32x4){c01[1], c01[3], c23[1], c23[3]};
                }
#pragma unroll
                for (int bj = 0; bj < 2; ++bj) {
                    f32x4 x1 = x[bj][0], x2 = x[bj][1];
                    if (isq) { x1 = x1 * 0.17677669529663687f; x2 = x2 * 0.17677669529663687f; }
                    const f32x4 o1 = x1 * cs - x2 * sn, o2 = x2 * cs + x1 * sn;
                    bf16* d = QLK + (size_t)r * 256 + wc * 64 + 32 * bj;
                    u32x2 w1, w2; w1.x = cvt_pk_bf16(o1[0], o1[1]); w1.y = cvt_pk_bf16(o1[2], o1[3]); w2.x = cvt_pk_bf16(o2[0], o2[1]); w2.y = cvt_pk_bf16(o2[2], o2[3]);
                    *(u32x2*)(d + off[0]) = w1; *(u32x2*)(d + off[1]) = w2;
                }
                EPI_FENCE(); } }
        } else if (pn == 9) {
            bf16* GS = wsptr<bf16>(w, WS_GS); EPIA_CVV
            EPIA_LOOP { EPIA_X(ai, m)
#pragma unroll
                for (int bj = 0; bj < 2; ++bj) { f32x4 a = x[bj][0], b = x[bj][1];
#pragma unroll
                    for (int i = 0; i < 4; ++i) { a[i] = siluf(a[i]); b[i] = siluf(b[i]); }
                    *(u32x4*)(GS + (size_t)r * 256 + wc * 64 + 32 * bj + 8 * fq) = pack8(a, b); }
                EPI_FENCE(); } }
        } else {
            float* LR = wsptr<float>(w, WS_LR);
            if (wc == 0) { EPIA_CVV
                EPIA_LOOP { EPIA_X(ai, m)
#pragma unroll
                    for (int n = 0; n < 2; ++n) *(f32x4*)(LR + (size_t)r * 32 + 8 * fq + 4 * n) = x[0][n];
                    EPI_FENCE(); } }
            }
        }
#undef EPIA_CVV
#undef EPIA_X
#undef EPIA_RS
#undef EPIA_LOOP
    }
};

struct EpiRes {
    static constexpr bool IDEMPOTENT = false, PREF = true;
    unsigned char* ws; const float* base_ctx; const float* base_lat;   const bf16* base_h;
    float* out;   bf16* dst_h;   int gate_off;
    int wsc_off;   int rowss_off; int dry;
    __device__ __forceinline__ void pref(LAS unsigned char* dst, const pg8::Unit& u, int wid, int lane) const {
        if (wid < 2) {
            GAS unsigned char* wg_ = (GAS unsigned char*)ws; asm volatile("" : "+s"(wg_)); unsigned char* w = (unsigned char*)wg_;
            const int ci = cond_of_pm(u.pm);
            const float* src;
            if (wid == 0) src = wsptr<float>(w, WS_MODS) + gate_off + (size_t)ci * 6144 + u.pn * 256 + lane * 4;
            else src = wsptr<float>(w, WS_WSC) + (wsc_off >= 0 ? wsc_off : 0) + (size_t)ci * DM + u.pn * 256 + lane * 4;
            __builtin_amdgcn_global_load_lds((const unsigned*)src, (LAS unsigned*)(dst + wid * 1024), 16, 0, 0);
        }
    }
    template <int NAI, int NM, bool PF> __device__ __forceinline__ void run(AccRef acc, const pg8::Unit& u, int wr, int wc, int fr_, int fq_, const LAS float* Pf) const {
        GAS unsigned char* wg_ = (GAS unsigned char*)ws; int fr = fr_, fq = fq_; asm volatile("" : "+s"(wg_), "+v"(fr), "+v"(fq)); unsigned char* w = (unsigned char*)wg_;
        const int pn = u.pn, pm = u.pm, ci = cond_of_pm(pm);
        const int colb = pn * 256 + wc * 32 + 8 * fq;
        const bool more = wsc_off >= 0;
        const float* gate = wsptr<float>(w, WS_MODS) + gate_off + (size_t)ci * 6144 + colb;
        const float* wsc = wsptr<float>(w, WS_WSC) + (more ? wsc_off : 0) + (size_t)ci * DM + colb;
        float* rowss = wsptr<float>(w, WS_ROWSS) + rowss_off;
        bf16* XA = wsptr<bf16>(w, WS_XA);
        const int rl0 = u.rsh + wr * 64 + fr;
        f32x4 gt[2][2], wsv[2][2];
#pragma unroll
        for (int bj = 0; bj < 2; ++bj)
#pragma unroll
            for (int n = 0; n < 2; ++n) {
                if constexpr (PF) { gt[bj][n] = *(const LAS f32x4*)(Pf + wc * 32 + 8 * fq + 128 * bj + 4 * n); wsv[bj][n] = *(const LAS f32x4*)(Pf + 256 + wc * 32 + 8 * fq + 128 * bj + 4 * n); }
                else { gt[bj][n] = *(const f32x4*)(gate + 128 * bj + 4 * n); wsv[bj][n] = *(const f32x4*)(wsc + 128 * bj + 4 * n); } }
        auto body = [&](auto bb_, auto db_) __attribute__((always_inline)) {
            constexpr bool BB = decltype(bb_)::value, DB = decltype(db_)::value;
            const float* bp0 = (pm < 16) ? (base_ctx + (size_t)(pm * 256) * DM) : (base_lat + (size_t)(pm * 256 - M_CTX) * DM);
            const bf16* bh0 = base_h + (size_t)(pm * 256) * DM;
#pragma unroll
            for (int am = 0; am < NAI * NM / 2; ++am) {
                const int ai = am >> 1, m0 = (am & 1) * 2;
                f32x4 pre[2][2][2]; u32x4 preh[2][2];
#pragma unroll
                for (int mm = 0; mm < 2; ++mm)
#pragma unroll
                    for (int bj = 0; bj < 2; ++bj) {
                        const size_t ro = (size_t)(rl0 + ai * 128 + (m0 + mm) * 16) * DM + colb + 128 * bj;
                        if constexpr (BB) preh[mm][bj] = *(const u32x4*)(bh0 + ro);
                        else { pre[mm][bj][0] = *(const f32x4*)(bp0 + ro); pre[mm][bj][1] = *(const f32x4*)(bp0 + ro + 4); }
                    }
#pragma unroll
                for (int mm = 0; mm < 2; ++mm) {
                    const int m = m0 + mm, rl = rl0 + ai * 128 + m * 16;
                    float ss = 0.f;
#pragma unroll
                    for (int bj = 0; bj < 2; ++bj) {
                        const size_t oo = (size_t)(pm * 256 + rl) * DM + colb + 128 * bj;
                        f32x4 b0, b1;
                        if constexpr (BB) { const u32x4 hw = preh[mm][bj]; b0 = (f32x4){bflo(hw.x), bfhi(hw.x), bflo(hw.y), bfhi(hw.y)}; b1 = (f32x4){bflo(hw.z), bfhi(hw.z), bflo(hw.w), bfhi(hw.w)}; }
                        else { b0 = pre[mm][bj][0]; b1 = pre[mm][bj][1]; }
                        const f32x4 v0 = b0 + gt[bj][0] * acc[ai][bj][m][0], v1 = b1 + gt[bj][1] * acc[ai][bj][m][1];
                        if (!dry) { if constexpr (DB) *(u32x4*)(dst_h + oo) = pack8(v0, v1); else { *(f32x4*)(out + oo) = v0; *(f32x4*)(out + oo + 4) = v1; } }
                        ss += ((v0[0] * v0[0] + v0[1] * v0[1]) + (v0[2] * v0[2] + v0[3] * v0[3])) + ((v1[0] * v1[0] + v1[1] * v1[1]) + (v1[2] * v1[2] + v1[3] * v1[3]));
                        if (more && !dry) *(u32x4*)(XA + oo) = pack8(v0 * wsv[bj][0], v1 * wsv[bj][1]);
                    }
                    if (more) { ss += __shfl_xor(ss, 16); ss += __shfl_xor(ss, 32); if (fq == 0) atomicAdd(rowss + pm * 256 + rl, ss); }
                }
                EPI_FENCE();
            }
        };
        if (base_h) { if (dst_h) body(std::true_type{}, std::true_type{}); else body(std::true_type{}, std::false_type{}); }
        else body(std::false_type{}, std::true_type{});
    }
};

struct EpiD {
    static constexpr bool IDEMPOTENT = true, PREF = true;
    unsigned char* ws; int layer;
    __device__ __forceinline__ void pref(LAS unsigned char* dst, const pg8::Unit& u, int wid, int lane) const {
        if (wid < 2) {
            GAS unsigned char* wg_ = (GAS unsigned char*)ws; asm volatile("" : "+s"(wg_)); unsigned char* w = (unsigned char*)wg_;
            const float* src;
            if (wid == 0) src = wsptr<float>(w, WS_ROWSS) + (size_t)(2 * layer + 1) * M + u.pm * 256 + lane * 4;
            else src = wsptr<float>(w, WS_CVD) + ((size_t)layer * NCOND + cond_of_pm(u.pm)) * FF2 + u.pn * 128 + ((lane < 32) ? lane * 4 : DFF + (lane - 32) * 4);
            __builtin_amdgcn_global_load_lds((const unsigned*)src, (LAS unsigned*)(dst + wid * 1024), 16, 0, 0);
        }
    }
    template <int NAI, int NM, bool PF> __device__ __forceinline__ void run(AccRef acc, const pg8::Unit& u, int wr, int wc, int fr_, int fq_, const LAS float* Pf) const {
        GAS unsigned char* wg_ = (GAS unsigned char*)ws; int fr = fr_, fq = fq_; asm volatile("" : "+s"(wg_), "+v"(fr), "+v"(fq)); unsigned char* w = (unsigned char*)wg_;
        const int pn = u.pn, pm = u.pm, ci = cond_of_pm(pm);
        const int jb = pn * 128 + wc * 32 + 8 * fq;
        const float* rowss = wsptr<float>(w, WS_ROWSS) + (size_t)(2 * layer + 1) * M;
        const float* cvec = wsptr<float>(w, WS_CVD) + ((size_t)layer * NCOND + ci) * FF2 + jb;
        bf16* H = wsptr<bf16>(w, WS_H);
        f32x4 cg[2], cu[2];
        float rsv[2][4];
        if constexpr (PF) {
#pragma unroll
            for (int n = 0; n < 2; ++n) { cg[n] = *(const LAS f32x4*)(Pf + 256 + wc * 32 + 8 * fq + 4 * n); cu[n] = *(const LAS f32x4*)(Pf + 384 + wc * 32 + 8 * fq + 4 * n); }
#pragma unroll
            for (int ai = 0; ai < NAI; ++ai)
#pragma unroll
                for (int m = 0; m < NM; ++m) rsv[ai][m] = Pf[ai * 128 + wr * 64 + m * 16 + fr];
        } else {
#pragma unroll
            for (int n = 0; n < 2; ++n) { cg[n] = *(const f32x4*)(cvec + 4 * n); cu[n] = *(const f32x4*)(cvec + DFF + 4 * n); }
#pragma unroll
            for (int ai = 0; ai < NAI; ++ai)
#pragma unroll
                for (int m = 0; m < NM; ++m) rsv[ai][m] = rowss[pm * 256 + u.rsh + ai * 128 + wr * 64 + m * 16 + fr];
        }
#pragma unroll
        for (int ai = 0; ai < NAI; ++ai)
#pragma unroll
            for (int m = 0; m < NM; ++m) rsv[ai][m] = rsqrtf(rsv[ai][m] * (1.0f / DM) + EPS);
#pragma unroll
        for (int n = 0; n < 2; ++n) { cg[n] = cg[n] * -1.4426950408889634f; cu[n] = cu[n] * -0.6931471805599453f; }
#pragma unroll
        for (int ai = 0; ai < NAI; ++ai)
#pragma unroll
            for (int m = 0; m < NM; ++m) {
                const int r = pm * 256 + u.rsh + ai * 128 + wr * 64 + m * 16 + fr;
                const float rs2 = rsv[ai][m] * -1.4426950408889634f, rs3 = rsv[ai][m] * -0.6931471805599453f;
                f32x4 h[2];
#pragma unroll
                for (int n = 0; n < 2; ++n) { const f32x4 g2 = acc[ai][0][m][n] * rs2 + cg[n], u3 = acc[ai][1][m][n] * rs3 + cu[n];
#pragma unroll
                    for (int i = 0; i < 4; ++i) h[n][i] = (g2[i] * u3[i]) * __builtin_amdgcn_rcpf(1.0f + __builtin_amdgcn_exp2f(g2[i])); }
                *(u32x4*)(H + (size_t)r * DFF + jb) = pack8(h[0], h[1]);
                if (m & 1) EPI_FENCE();
            }
    }
};

#define XB_TMO      128
#define XB_XCNT(j)  (256  + 64 * (j))
#define XB_XSUB(j)  (1280 + 64 * (j))
#define XB_XGEN(j)  (2304 + 64 * (j))
#define XB_TOP      3328
#define XB_TOPGEN   3392
#define XCD_BAR_WORDS 3456
#define XB_SPIN_CAP (1u << 18)
__device__ __forceinline__ unsigned xb_ld(unsigned* p)              { return __hip_atomic_load(p, __ATOMIC_RELAXED, __HIP_MEMORY_SCOPE_AGENT); }
__device__ __forceinline__ unsigned xb_add(unsigned* p, unsigned v) { return __hip_atomic_fetch_add(p, v, __ATOMIC_RELAXED, __HIP_MEMORY_SCOPE_AGENT); }
__device__ __forceinline__ unsigned xb_xcc_id() { return (unsigned)__builtin_amdgcn_s_getreg((3 << 11) | 20) & 0xFu; }
#define XB_SPIN(cond, bar) do { unsigned _sp = 0; while (cond) { __builtin_amdgcn_s_sleep(1); \
    if ((++_sp & 255u) == 0u) { if (xb_ld(&(bar)[XB_TMO])) break; if (_sp > XB_SPIN_CAP) { atomicAdd(&(bar)[XB_TMO], 1u); break; } } } } while (0)
struct XcdBarrier { unsigned* bar; unsigned x; volatile LAS unsigned* st; };
__device__ __forceinline__ XcdBarrier xcd_barrier_post(unsigned* bar, volatile LAS unsigned* st) {
    XcdBarrier b; b.bar = bar; b.x = xb_xcc_id(); b.st = st;
    if (threadIdx.x == 0) (void)xb_add(&bar[XB_XCNT(b.x)], 1u);
    return b;
}
__device__ __forceinline__ void xcd_barrier_complete(unsigned* bar, unsigned x, unsigned& nloc, unsigned& nx) {
    const unsigned G = gridDim.x * gridDim.y * gridDim.z;
    unsigned sum, cnt, mine, sp = 0u;
    for (;;) {
        sum = 0u; cnt = 0u; mine = 0u;
#pragma unroll
        for (unsigned j = 0; j < 16; ++j) { const unsigned c = xb_ld(&bar[XB_XCNT(j)]); sum += c; cnt += (c > 0u) ? 1u : 0u; mine = (j == x) ? c : mine; }
        if (sum == G) break;
        __builtin_amdgcn_s_sleep(1);
        if ((++sp & 255u) == 0u) { if (xb_ld(&bar[XB_TMO])) break; if (sp > XB_SPIN_CAP) { atomicAdd(&bar[XB_TMO], 1u); break; } }
    }
    nloc = mine > 0u ? mine : 1u; nx = cnt > 0u ? cnt : 1u;
}
#define XB_SXSUB(j) (3520 + 64 * (j))
#define XB_STOP     4544
#define XB_SGEN     4608
__device__ __forceinline__ void xcd_split_arrive(const XcdBarrier& b) {
    asm volatile("s_waitcnt vmcnt(0)" ::: "memory");
    __syncthreads();
    if (threadIdx.x == 0) {
        unsigned* bar = b.bar;
        __builtin_amdgcn_s_waitcnt(0);
        unsigned nloc = b.st[0], nx = b.st[1];
        if (nloc == 0u) { xcd_barrier_complete(bar, b.x, nloc, nx); b.st[0] = nloc; b.st[1] = nx; }
        const unsigned old = xb_add(&bar[XB_SXSUB(b.x)], 1u);
        const unsigned gen = old / nloc;
        if (old + 1u == (gen + 1u) * nloc) {
            __builtin_amdgcn_fence(__ATOMIC_RELEASE, "agent");
            asm volatile("s_waitcnt vmcnt(0)" ::: "memory");
            const unsigned og = xb_add(&bar[XB_STOP], 1u);
            const unsigned tg = og / nx;
            if (og + 1u == (tg + 1u) * nx) xb_add(&bar[XB_SGEN], 1u);
        }
        b.st[2] = gen + 1u;
    }
}
__device__ __forceinline__ void xcd_split_wait(const XcdBarrier& b) {
    if (threadIdx.x == 0) {
        unsigned* bar = b.bar;
        const unsigned target = b.st[2];
        XB_SPIN(xb_ld(&bar[XB_SGEN]) < target, bar);
        __builtin_amdgcn_fence(__ATOMIC_ACQUIRE, "agent");
        asm volatile("s_waitcnt vmcnt(0)" ::: "memory");
    }
    __syncthreads();
}
__device__ __forceinline__ void xcd_barrier(const XcdBarrier& b) {
    asm volatile("s_waitcnt vmcnt(0)" ::: "memory");
    __syncthreads();
    if (threadIdx.x == 0) {
        unsigned* bar = b.bar;
        __builtin_amdgcn_s_waitcnt(0);
        unsigned nloc = b.st[0], nx = b.st[1];
        if (nloc == 0u) { xcd_barrier_complete(bar, b.x, nloc, nx); b.st[0] = nloc; b.st[1] = nx; }
        const unsigned old = xb_add(&bar[XB_XSUB(b.x)], 1u);
        const unsigned gen = old / nloc;
        if (old + 1u == (gen + 1u) * nloc) {
            __builtin_amdgcn_fence(__ATOMIC_RELEASE, "agent");
            asm volatile("s_waitcnt vmcnt(0)" ::: "memory");
            const unsigned og = xb_add(&bar[XB_TOP], 1u);
            const unsigned tg = og / nx;
            if (og + 1u == (tg + 1u) * nx) xb_add(&bar[XB_TOPGEN], 1u);
            else XB_SPIN(xb_ld(&bar[XB_TOPGEN]) == tg, bar);
            __builtin_amdgcn_fence(__ATOMIC_ACQUIRE, "agent");
            xb_add(&bar[XB_XGEN(b.x)], 1u);
            asm volatile("s_waitcnt vmcnt(0)" ::: "memory");
        } else {
            XB_SPIN(xb_ld(&bar[XB_XGEN(b.x)]) == gen, bar);
            __builtin_amdgcn_fence(__ATOMIC_ACQUIRE, "agent");
            asm volatile("s_waitcnt vmcnt(0)" ::: "memory");
        }
    }
    __syncthreads();
}


typedef short s16x4 __attribute__((ext_vector_type(4)));
#ifndef NA_NAIVE
#define NA_NAIVE 0
#endif
__device__ __forceinline__ int na_off(int row, int ch) { return row * 128 + ((ch ^ (row & 7)) << 4); }
__device__ __forceinline__ int off64(int row, int ch) { return row * 64 + ((ch ^ ((row >> 2) & 3)) << 4); }
__device__ __forceinline__ int doff(int row, int ch) { return row * 512 + ((ch ^ (row & 15)) << 4); }
#ifndef GLA_NAIVE
#define GLA_NAIVE 0
#endif
#ifndef POOL_NAIVE
#define POOL_NAIVE 0
#endif
__device__ __forceinline__ f32x4 na_qk(LAS unsigned char* kb, int krow, int lane, const bf16x8 qf0, const bf16x8 qf1, const f32x4 cin) {
    const int key = krow + (lane & 15), g = lane >> 4;
    const bf16x8 k0 = *(const LAS bf16x8*)(kb + na_off(key, g));
    const bf16x8 k1 = *(const LAS bf16x8*)(kb + na_off(key, 4 + g));
    f32x4 acc = __builtin_amdgcn_mfma_f32_16x16x32_bf16(k0, qf0, cin, 0, 0, 0);
    acc = __builtin_amdgcn_mfma_f32_16x16x32_bf16(k1, qf1, acc, 0, 0, 0);
    return acc;
}
__device__ __forceinline__ s16x4 na_tr(LAS unsigned char* p) { return __builtin_bit_cast(s16x4, __builtin_amdgcn_ds_read_tr16_b64_v4i16((LAS s16x4*)p)); }
__device__ __forceinline__ void na_pv(LAS unsigned char* vb, int kb0, int kb1, int lane, const bf16x8 pf, f32x4 (&o)[4]) {
    const int g = lane >> 4, q = (lane & 15) >> 2, p = lane & 3;
    const int r0 = kb0 + 4 * g + q, r1 = kb1 + 4 * g + q;
#pragma unroll
    for (int c = 0; c < 4; ++c) {
        const s16x4 lo = na_tr(vb + na_off(r0, 2 * c + (p >> 1)) + 8 * (p & 1));
        const s16x4 hi = na_tr(vb + na_off(r1, 2 * c + (p >> 1)) + 8 * (p & 1));
        const bf16x8 vf = (bf16x8){lo[0], lo[1], lo[2], lo[3], hi[0], hi[1], hi[2], hi[3]};
        o[c] = __builtin_amdgcn_mfma_f32_16x16x32_bf16(vf, pf, o[c], 0, 0, 0);
    }
}
__device__ __forceinline__ f32x4 na_qk_old(LAS unsigned char* kb, int krow, int lane, const bf16x8 qf0, const bf16x8 qf1) {
    const int key = krow + (lane & 15), g = lane >> 4;
    f32x4 acc = (f32x4){0.f, 0.f, 0.f, 0.f};
    const bf16x8 k0 = *(const LAS bf16x8*)(kb + na_off(key, g));
    const bf16x8 k1 = *(const LAS bf16x8*)(kb + na_off(key, 4 + g));
    acc = __builtin_amdgcn_mfma_f32_16x16x32_bf16(k0, qf0, acc, 0, 0, 0);
    acc = __builtin_amdgcn_mfma_f32_16x16x32_bf16(k1, qf1, acc, 0, 0, 0);
    return acc;
}
template <int NT>
__device__ __forceinline__ void na_softmax(f32x4 (&s)[NT], float& m, float& l, f32x4 (&o)[4], bf16x8 (&pf)[NT / 2]) {
    float mx = __builtin_elementwise_maximum(__builtin_elementwise_maximum(s[0][0], s[0][1]), s[0][2]);
    {   float m2 = s[0][3];
#pragma unroll
        for (int t = 1; t < NT; ++t) { m2 = __builtin_elementwise_maximum(__builtin_elementwise_maximum(m2, s[t][0]), s[t][1]); mx = __builtin_elementwise_maximum(__builtin_elementwise_maximum(mx, s[t][2]), s[t][3]); }
        mx = __builtin_elementwise_maximum(mx, m2); }
    mx = fmaxf(mx, __shfl_xor(mx, 16)); mx = fmaxf(mx, __shfl_xor(mx, 32));
    const float mn = fmaxf(m, mx);
    const float al = __builtin_amdgcn_exp2f(m - mn);
    m = mn;
    float sum = 0.f;
#pragma unroll
    for (int t = 0; t < NT; ++t)
#pragma unroll
        for (int i = 0; i < 4; ++i) { s[t][i] = __builtin_amdgcn_exp2f(s[t][i] - mn); sum += s[t][i]; }
    l = l * al + sum;
#pragma unroll
    for (int c = 0; c < 4; ++c) o[c] = o[c] * al;
#pragma unroll
    for (int t = 0; t < NT / 2; ++t) {
        const unsigned w0 = cvt_pk_bf16(s[2 * t][0], s[2 * t][1]), w1 = cvt_pk_bf16(s[2 * t][2], s[2 * t][3]);
        const unsigned w2 = cvt_pk_bf16(s[2 * t + 1][0], s[2 * t + 1][1]), w3 = cvt_pk_bf16(s[2 * t + 1][2], s[2 * t + 1][3]);
        pf[t] = __builtin_bit_cast(bf16x8, (u32x4){w0, w1, w2, w3});
    }
}


__device__ __forceinline__ void na_kfrag(LAS unsigned char* kb, int krow, int lane, bf16x8& k0, bf16x8& k1) {
    const int key = krow + (lane & 15), g = lane >> 4;
    k0 = *(const LAS bf16x8*)(kb + na_off(key, g)); k1 = *(const LAS bf16x8*)(kb + na_off(key, 4 + g));
}
__device__ __forceinline__ f32x4 na_qk2(const bf16x8 k0, const bf16x8 k1, const bf16x8 qf0, const bf16x8 qf1, const f32x4 cin) {
    f32x4 acc = __builtin_amdgcn_mfma_f32_16x16x32_bf16(k0, qf0, cin, 0, 0, 0);
    return __builtin_amdgcn_mfma_f32_16x16x32_bf16(k1, qf1, acc, 0, 0, 0);
}
__device__ __forceinline__ bf16x8 na_vfrag(LAS unsigned char* vb, int kb0, int kb1, int lane, int c) {
    const int g = lane >> 4, q = (lane & 15) >> 2, p = lane & 3;
    const s16x4 lo = na_tr(vb + na_off(kb0 + 4 * g + q, 2 * c + (p >> 1)) + 8 * (p & 1));
    const s16x4 hi = na_tr(vb + na_off(kb1 + 4 * g + q, 2 * c + (p >> 1)) + 8 * (p & 1));
    return (bf16x8){lo[0], lo[1], lo[2], lo[3], hi[0], hi[1], hi[2], hi[3]};
}
template <int NT>
__device__ __forceinline__ void na_sm(f32x4 (&s)[NT], f32x4& cinv, f32x4 (&mk)[2], const bool first, f32x4 (&o)[4], f32x4& osum, bf16x8 (&pf)[NT / 2], float& dl_out) {
    float mx = __builtin_elementwise_maximum(__builtin_elementwise_maximum(s[0][0], s[0][1]), s[0][2]);
    {   float m2 = s[0][3];
#pragma unroll
        for (int t = 1; t < NT; ++t) { m2 = __builtin_elementwise_maximum(__builtin_elementwise_maximum(m2, s[t][0]), s[t][1]); mx = __builtin_elementwise_maximum(__builtin_elementwise_maximum(mx, s[t][2]), s[t][3]); }
        mx = __builtin_elementwise_maximum(mx, m2); }
    dl_out = 0.f;
    if (first || __ballot(mx > 8.0f) != 0ull) {
        mx = fmaxf(mx, __shfl_xor(mx, 16)); mx = fmaxf(mx, __shfl_xor(mx, 32));
        const float dl = first ? mx : fmaxf(mx, 0.f);
        cinv = cinv - dl; mk[0] = mk[0] - dl; mk[1] = mk[1] - dl; dl_out = dl;
#pragma unroll
        for (int t = 0; t < NT; ++t) s[t] = s[t] - dl;
        if (!first) { const float al = __builtin_amdgcn_exp2f(-dl);
#pragma unroll
            for (int c = 0; c < 4; ++c) o[c] = o[c] * al;
            osum = osum * al; }
    }
#pragma unroll
    for (int t = 0; t < NT; ++t)
#pragma unroll
        for (int i = 0; i < 4; ++i) s[t][i] = __builtin_amdgcn_exp2f(s[t][i]);
#pragma unroll
    for (int t = 0; t < NT / 2; ++t) {
        const unsigned w0 = cvt_pk_bf16(s[2 * t][0], s[2 * t][1]), w1 = cvt_pk_bf16(s[2 * t][2], s[2 * t][3]);
        const unsigned w2 = cvt_pk_bf16(s[2 * t + 1][0], s[2 * t + 1][1]), w3 = cvt_pk_bf16(s[2 * t + 1][2], s[2 * t + 1][3]);
        pf[t] = __builtin_bit_cast(bf16x8, (u32x4){w0, w1, w2, w3});
    }
}
__device__ __forceinline__ void na_sm_pre2(f32x4 (&s)[2], f32x4& cinv, f32x4 (&mk)[2], const bool first, f32x4 (&o)[4], f32x4& osum) {
    float mx = __builtin_elementwise_maximum(__builtin_elementwise_maximum(s[0][0], s[0][1]), s[0][2]);
    {   float m2 = s[0][3];
        m2 = __builtin_elementwise_maximum(__builtin_elementwise_maximum(m2, s[1][0]), s[1][1]); mx = __builtin_elementwise_maximum(__builtin_elementwise_maximum(mx, s[1][2]), s[1][3]);
        mx = __builtin_elementwise_maximum(mx, m2); }
    if (first || __ballot(mx > 8.0f) != 0ull) {
        mx = fmaxf(mx, __shfl_xor(mx, 16)); mx = fmaxf(mx, __shfl_xor(mx, 32));
        const float dl = first ? mx : fmaxf(mx, 0.f);
        cinv = cinv - dl; mk[0] = mk[0] - dl; mk[1] = mk[1] - dl;
        s[0] = s[0] - dl; s[1] = s[1] - dl;
        if (!first) { const float al = __builtin_amdgcn_exp2f(-dl);
#pragma unroll
            for (int c = 0; c < 4; ++c) o[c] = o[c] * al;
            osum = osum * al; }
    }
}
__device__ __forceinline__ bf16x8 na_pack2(const f32x4 (&s)[2]) {
    const unsigned w0 = cvt_pk_bf16(s[0][0], s[0][1]), w1 = cvt_pk_bf16(s[0][2], s[0][3]);
    const unsigned w2 = cvt_pk_bf16(s[1][0], s[1][1]), w3 = cvt_pk_bf16(s[1][2], s[1][3]);
    return __builtin_bit_cast(bf16x8, (u32x4){w0, w1, w2, w3});
}

struct Args {
    const float* in[26]; float* out; unsigned char* ws; int ph_lo, ph_hi;
};
enum { I_XP = 0, I_XS, I_C, I_CK, I_CV, I_SF, I_SB, I_CCTX, I_WADA, I_BADA, I_G1, I_G2, I_WIN, I_WPOOL, I_PSCALE, I_QG, I_KG, I_RELB,
       I_WGF, I_BGF, I_WGB, I_BGB, I_GLAG, I_WOUT, I_WFFI, I_WFFO };

constexpr int LDS_BYTES = 147456, RING_BYTES = 131072, MISC_OFF = RING_BYTES + 320;

__device__ __forceinline__ void smallm_item(LAS float* Al, LAS float* red, const float* W, int ldw, int n0, int nvalid, const float* bias, float* out, int ldo) {
    int tid = threadIdx.x; asm volatile("" : "+v"(tid));
    const int lane = tid & 63, w = tid >> 6;
    const int n = n0 + 2 * lane; const bool ok = n < nvalid;
    float acc[NCOND][2];
#pragma unroll
    for (int c = 0; c < NCOND; ++c) { acc[c][0] = 0.f; acc[c][1] = 0.f; }
    const int k0 = w * 128;
    for (int kb = k0; kb < k0 + 128; kb += 8) {
        f32x2 wv[8];
#pragma unroll
        for (int j = 0; j < 8; ++j) { wv[j] = (f32x2){0.f, 0.f}; if (ok) wv[j] = *(const f32x2*)(W + (size_t)(kb + j) * ldw + n); }
#pragma unroll
        for (int j = 0; j < 8; ++j)
#pragma unroll
            for (int c = 0; c < NCOND; ++c) { const float a = Al[c * 1024 + kb + j]; acc[c][0] += a * wv[j].x; acc[c][1] += a * wv[j].y; }
    }
#pragma unroll
    for (int c = 0; c < NCOND; ++c) { red[(w * NCOND + c) * 128 + 2 * lane] = acc[c][0]; red[(w * NCOND + c) * 128 + 2 * lane + 1] = acc[c][1]; }
    __syncthreads();
    for (int o = tid; o < NCOND * 128; o += 512) { const int c = o >> 7, j = o & 127; float s = 0.f;
#pragma unroll
        for (int ww = 0; ww < 8; ++ww) s += red[(ww * NCOND + c) * 128 + j];
        const int nn = n0 + j; if (nn < nvalid) out[(size_t)c * ldo + nn] = s + (bias ? bias[nn] : 0.f); }
    __syncthreads();
}

__device__ __forceinline__ void smallm_item_dma(LAS unsigned char* lds, const float* W, int ldw, int n0, const float* bias, float* out, int ldo) {
    int tid = threadIdx.x; asm volatile("" : "+v"(tid));
    const int lane = tid & 63, w = __builtin_amdgcn_readfirstlane(tid >> 6);
    const LAS float* Al = (const LAS float*)lds; LAS float* red = (LAS float*)(lds + 36864);
    LAS unsigned char* ring = lds + (w < 7 ? 36864 + w * 12288 : 131072 + 1024);
    float acc[NCOND][2];
#pragma unroll
    for (int c = 0; c < NCOND; ++c) { acc[c][0] = 0.f; acc[c][1] = 0.f; }
    const int k0 = w * 128;
    const float* src = W + (size_t)(k0 + (lane >> 5)) * ldw + n0 + 4 * (lane & 31);
#define SMD_ISSUE(ch_) do { _Pragma("unroll") for (int i_ = 0; i_ < 4; ++i_) \
        __builtin_amdgcn_global_load_lds((const unsigned*)(src + (size_t)((ch_) * 8 + 2 * i_) * ldw), (LAS unsigned*)(ring + ((ch_) % 3) * 4096 + i_ * 1024), 16, 0, 0); } while (0)
    asm volatile("s_waitcnt vmcnt(0)" ::: "memory");
    SMD_ISSUE(0); SMD_ISSUE(1); SMD_ISSUE(2);
#pragma unroll 1
    for (int ch = 0; ch < 16; ++ch) {
        if (ch + 2 < 16) asm volatile("s_waitcnt vmcnt(8)" ::: "memory"); else if (ch + 1 < 16) asm volatile("s_waitcnt vmcnt(4)" ::: "memory"); else asm volatile("s_waitcnt vmcnt(0)" ::: "memory");
        const LAS unsigned char* cb = ring + (ch % 3) * 4096 + lane * 8;
        f32x2 wv[8];
#pragma unroll
        for (int j = 0; j < 8; ++j) wv[j] = *(const LAS f32x2*)(cb + j * 512);
#pragma unroll
        for (int j = 0; j < 8; ++j)
#pragma unroll
            for (int c = 0; c < NCOND; ++c) { const float a = Al[c * 1024 + k0 + ch * 8 + j]; acc[c][0] += a * wv[j].x; acc[c][1] += a * wv[j].y; }
        asm volatile("s_waitcnt lgkmcnt(0)" ::: "memory");
        if (ch + 3 < 16) SMD_ISSUE(ch + 3);
    }
#undef SMD_ISSUE
    __syncthreads();
#pragma unroll
    for (int c = 0; c < NCOND; ++c) { red[(w * NCOND + c) * 128 + 2 * lane] = acc[c][0]; red[(w * NCOND + c) * 128 + 2 * lane + 1] = acc[c][1]; }
    __syncthreads();
    for (int o = tid; o < NCOND * 128; o += 512) { const int c = o >> 7, j = o & 127; float sm = 0.f;
#pragma unroll
        for (int ww = 0; ww < 8; ++ww) sm += red[(ww * NCOND + c) * 128 + j];
        const int nn = n0 + j; out[(size_t)c * ldo + nn] = sm + (bias ? bias[nn] : 0.f); }
    __syncthreads();
}

__device__ __forceinline__ void transpose_item(const float* W, int ldw, int K, int nphys, bf16* Wt, int kind, int item, LAS float* scr, int lane) {
    const int npb = nphys / 32, kb = item / npb, pb = item % npb, k0 = 64 * kb, p0 = 32 * pb;
    const int g0 = lgroup(kind, p0);
    const bool rope = (kind == 0) && ((p0 >> 8) == 7);
    const int pl = plow(rope, lane & 31);
#pragma unroll 8
    for (int i = 0; i < 32; ++i) { const int kk = 2 * i + (lane >> 5); scr[kk * 33 + pl] = (g0 >= 0) ? W[(size_t)(k0 + kk) * ldw + g0 + (lane & 31)] : 0.f; }
    asm volatile("s_waitcnt lgkmcnt(0)" ::: "memory");
    const int c = lane & 7;
#pragma unroll
    for (int j = 0; j < 4; ++j) { const int n = (lane >> 3) + 8 * j; const LAS float* s = scr + (8 * c) * 33 + n;
        u32x4 o; o.x = cvt_pk_bf16(s[0 * 33], s[1 * 33]); o.y = cvt_pk_bf16(s[2 * 33], s[3 * 33]); o.z = cvt_pk_bf16(s[4 * 33], s[5 * 33]); o.w = cvt_pk_bf16(s[6 * 33], s[7 * 33]);
        *(u32x4*)(Wt + (size_t)(p0 + n) * K + k0 + 8 * c) = o; }
    asm volatile("s_waitcnt lgkmcnt(0)" ::: "memory");
}

constexpr int NPHASE = 2 + 7 * DEPTH;
__device__ __forceinline__ const float* inptr(const Args& a, int i) { asm volatile("" : "+s"(i)); return (const float*)(GAS const float*)a.in[i]; }

__global__ void __launch_bounds__(512, 2) fwd_kernel(Args args) {
    extern __shared__ __attribute__((aligned(16))) unsigned char lds_raw[];
    LAS unsigned char* lds = (LAS unsigned char*)lds_raw;
    LAS float* ldsf = (LAS float*)lds;
    const int wave0 = __builtin_amdgcn_readfirstlane(threadIdx.x >> 6);
    const int G = gridDim.x, bid = blockIdx.x;
    unsigned char* ws = args.ws;
    float* out = args.out;
    volatile LAS unsigned* MISC = (volatile LAS unsigned*)(lds + MISC_OFF);
    for (int u = threadIdx.x; u < (LDS_BYTES - RING_BYTES) / 4; u += 512) ((LAS unsigned*)(lds + RING_BYTES))[u] = 0u;
    __syncthreads();
    unsigned* ctl = (unsigned*)(ws + WS_CTL);
    XcdBarrier bar; bar.bar = ctl + CW_BAR; bar.x = 0; bar.st = nullptr;
#if MK_ONE_LAUNCH
    bar = xcd_barrier_post(ctl + CW_BAR, MISC + 8);
#endif
    const int lo = args.ph_lo, hi = args.ph_hi;
#define IN_PH(k) (lo <= (k) && (k) < hi)
#define SEAM(k) do { if (IN_PH(k) && IN_PH((k) + 1)) xcd_barrier(bar); } while (0)
#define SPLIT_ARRIVE(k) do { if (IN_PH(k) && IN_PH((k) + 1)) xcd_split_arrive(bar); } while (0)
#define SPLIT_WAIT(k) do { if (IN_PH(k) && IN_PH((k) + 1)) xcd_split_wait(bar); } while (0)

#define mods ((float*)(wsl + WS_MODS))
#define cva ((float*)(wsl + WS_CVA))
#define cvd ((float*)(wsl + WS_CVD))
#define wsc ((float*)(wsl + WS_WSC))
#define ropet ((float*)(wsl + WS_ROPE))
#define rowss ((float*)(wsl + WS_ROWSS))
#define Win_t ((bf16*)(wsl + WS_WIN))
#define Wout_t ((bf16*)(wsl + WS_WOUT))
#define Wffi_t ((bf16*)(wsl + WS_WFFI))
#define Wffo_t ((bf16*)(wsl + WS_WFFO))
#define XA ((bf16*)(wsl + WS_XA))
#define Y ((bf16*)(wsl + WS_Y))
#define H ((bf16*)(wsl + WS_H))
#define XR ((bf16*)(wsl + WS_XR))
#define Ub ((bf16*)(wsl + WS_U))
#define Qb ((bf16*)(wsl + WS_Q))
#define Kb ((bf16*)(wsl + WS_K))
#define Vb ((bf16*)(wsl + WS_V))
#define QLK ((bf16*)(wsl + WS_QLK))
#define VL ((bf16*)(wsl + WS_VL))
#define GS ((bf16*)(wsl + WS_GS))
#define LR ((float*)(wsl + WS_LR))
#define UF ((float*)(wsl + WS_UF))
#define UB ((float*)(wsl + WS_UB))
#define SINF ((float*)(wsl + WS_SINF))
#define SINB ((float*)(wsl + WS_SINB))
#define DF ((float*)(wsl + WS_DF))
#define DB ((float*)(wsl + WS_DB))
#define CKb ((bf16*)(wsl + WS_CK))
#define QKT ((bf16*)(wsl + WS_QKT))
#define STF ((bf16*)(wsl + WS_STF))
#define STB ((bf16*)(wsl + WS_STB))
#define WPT ((bf16*)(wsl + WS_WPT))
#define CVb ((bf16*)(wsl + WS_CV))

#define WSL GAS unsigned char* wsg_ = (GAS unsigned char*)ws; GAS float* outg_ = (GAS float*)out; int tid; asm volatile("v_mbcnt_lo_u32_b32 %0, -1, 0\n\tv_mbcnt_hi_u32_b32 %0, -1, %0" : "=v"(tid)); tid += wave0 * 64; asm volatile("" : "+s"(wsg_), "+s"(outg_), "+v"(tid)); unsigned char* wsl = (unsigned char*)wsg_; float* outl = (float*)outg_; const int lane = tid & 63, wave = __builtin_amdgcn_readfirstlane(tid >> 6); (void)lane; (void)wave;
#define INP(i) inptr(args, (i))
    for (int rep_ = 1 + ((REPEAT_MASK >> 0) & 1); rep_ > 0 && IN_PH(0); --rep_) { WSL
        LAS float* Al = ldsf; LAS float* red = ldsf + NCOND * 1024;
        bool filled = false;
        for (int it = bid; it < DEPTH * 48; it += G) {
            if (!filled) {
                for (int o = tid; o < NCOND * 1024; o += 512) { const int c = o >> 10, k = o & 1023; const float v = (c < 8) ? INP(I_C)[c * 1024 + k] : INP(I_CCTX)[k]; Al[o] = siluf(v); }
                __syncthreads(); filled = true;
            }
            const int l = it / 48, n0 = (it % 48) * 128;
            (void)red; smallm_item_dma(lds, INP(I_WADA) + (size_t)l * DM * 6144, 6144, n0, INP(I_BADA) + l * 6144, mods + (size_t)l * NCOND * 6144, 6144);
        }
        __syncthreads();
    }
    SPLIT_ARRIVE(0);
    for (int rep_ = 1 + ((REPEAT_MASK >> 1) & 1); rep_ > 0 && IN_PH(1); --rep_) { WSL
        const int gw = bid * 8 + wave, NGW = G * 8;
        {
            constexpr int I_A = 16 * (IN_WP / 32), I_C_ = 16 * 32, I_D = 16 * (FF2 / 32), I_E = (DFF / 64) * 32, I_L = I_A + I_C_ + I_D + I_E;
            LAS unsigned char* slot0 = lds + wave * 16384;
            struct TDesc { const float* src; bf16* dst; int K, kind, p0, g0, k0; };
            auto tdesc = [&](int it, TDesc& D) __attribute__((always_inline)) {
                const int l = it / I_L; int r = it % I_L; const float* W; int ldw, nphys;
                if (r < I_A) { W = INP(I_WIN) + (size_t)l * DM * IN_W; ldw = IN_W; D.K = DM; nphys = IN_WP; D.dst = Win_t + (size_t)l * IN_WP * DM; D.kind = 0; }
                else if ((r -= I_A) < I_C_) { W = INP(I_WOUT) + (size_t)l * DM * DM; ldw = DM; D.K = DM; nphys = DM; D.dst = Wout_t + (size_t)l * DM * DM; D.kind = 1; }
                else if ((r -= I_C_) < I_D) { W = INP(I_WFFI) + (size_t)l * DM * FF2; ldw = FF2; D.K = DM; nphys = FF2; D.dst = Wffi_t + (size_t)l * FF2 * DM; D.kind = 2; }
                else { r -= I_D; W = INP(I_WFFO) + (size_t)l * DFF * DM; ldw = DM; D.K = DFF; nphys = DM; D.dst = Wffo_t + (size_t)l * DM * DFF; D.kind = 1; }
                const int npb = nphys / 32, kb = r / npb, pb = r % npb; D.k0 = 64 * kb; D.p0 = 32 * pb; D.g0 = lgroup(D.kind, D.p0);
                D.src = W + (size_t)(D.k0 + (lane >> 3)) * ldw + (D.g0 >= 0 ? D.g0 : 0);
            };
            auto tissue = [&](int it, int sl) __attribute__((always_inline)) {
                const int l = it / I_L; int r = it % I_L; int ldw;
                if (r < I_A) ldw = IN_W; else if ((r -= I_A) < I_C_) ldw = DM; else if ((r -= I_C_) < I_D) ldw = FF2; else ldw = DM; (void)l;
                TDesc D; tdesc(it, D);
#pragma unroll
                for (int i = 0; i < 8; ++i) { const int ch = (lane & 7) ^ (((lane >> 3) + i) & 7);
                    __builtin_amdgcn_global_load_lds((const unsigned*)(D.src + (size_t)(8 * i) * ldw + 4 * ch), (LAS unsigned*)(slot0 + sl * 8192 + i * 1024), 16, 0, 0); }
            };
            const int nit = (DEPTH * I_L - gw + NGW - 1) / NGW;
            asm volatile("s_waitcnt vmcnt(0)" ::: "memory");
            if (nit > 0) tissue(gw, 0);
            if (nit > 1) tissue(gw + NGW, 1);
            for (int i = 0; i < nit; ++i) {
                const int it = gw + i * NGW;
                if (i + 1 < nit) asm volatile("s_waitcnt vmcnt(8)" ::: "memory"); else asm volatile("s_waitcnt vmcnt(0)" ::: "memory");
                TDesc D; tdesc(it, D);
                const bool rope = (D.kind == 0) && ((D.p0 >> 8) == 7);
                const LAS unsigned char* sb = slot0 + (i & 1) * 8192;
                const int c = lane & 7;
                u32x4 o[4];
#pragma unroll
                for (int j = 0; j < 4; ++j) { const int n = (lane >> 3) + 8 * j, l5 = llow5(rope, n);
                    float v[8];
#pragma unroll
                    for (int r8 = 0; r8 < 8; ++r8) v[r8] = *(const LAS float*)(sb + c * 1024 + r8 * 128 + (((l5 >> 2) ^ ((r8 + c) & 7)) << 4) + (l5 & 3) * 4);
                    if (D.g0 < 0) {
#pragma unroll
                        for (int r8 = 0; r8 < 8; ++r8) v[r8] = 0.f; }
                    o[j].x = cvt_pk_bf16(v[0], v[1]); o[j].y = cvt_pk_bf16(v[2], v[3]); o[j].z = cvt_pk_bf16(v[4], v[5]); o[j].w = cvt_pk_bf16(v[6], v[7]); }
                asm volatile("s_waitcnt lgkmcnt(0)" ::: "memory");
                if (i + 2 < nit) tissue(it + 2 * NGW, i & 1);
#pragma unroll
                for (int j = 0; j < 4; ++j) { const int n = (lane >> 3) + 8 * j; *(u32x4*)(D.dst + (size_t)(D.p0 + n) * D.K + D.k0 + 8 * c) = o[j]; }
            }
            asm volatile("s_waitcnt vmcnt(0)" ::: "memory");
        }
        if (bid == (G > 1 ? 1 : 0) && tid < 8) {
            const double th = ((tid & 1) ? 0.31622776601683794 : 1.0) * ((tid >> 1) == 0 ? 1.0 : ((tid >> 1) == 1 ? 0.1 : ((tid >> 1) == 2 ? 0.01 : 0.001)));
            double c1 = 1.0, s1 = 0.0; { double term = 1.0; double cs = 1.0, sn = 0.0; const double t2 = th * th;
                for (int k = 1; k <= 12; ++k) { term *= th / (2 * k - 1); sn += ((k & 1) ? term : -term); term *= th / (2 * k); cs += ((k & 1) ? -term : term); } c1 = cs; s1 = sn; (void)t2; }
            double c = 1.0, s = 0.0;
            for (int pos = 0; pos < 64; ++pos) { ropet[(pos * 8 + tid) * 2] = (float)c; ropet[(pos * 8 + tid) * 2 + 1] = (float)s; const double cn = c * c1 - s * s1, sn2 = s * c1 + c * s1; c = cn; s = sn2; }
        }
        for (int o = bid * 512 + tid; o < DEPTH * 4 * 64 * 64; o += G * 512) { const int c = o & 63, dd = (o >> 6) & 63, lg = o >> 12;
            WPT[o] = (bf16)(cvt_pk_bf16(INP(I_WPOOL)[((size_t)lg * 64 + c) * 64 + dd], 0.f) & 0xffffu); }
        for (size_t o = ((size_t)bid * 512 + tid) * 8; o < (size_t)2 * 4194304; o += (size_t)G * 512 * 8) {
            const bool isv = o >= 4194304; const size_t e = isv ? o - 4194304 : o;
            const float* s = (isv ? INP(I_CV) : INP(I_CK)) + e;
            const f32x4 a = *(const f32x4*)s, b = *(const f32x4*)(s + 4);
            *(u32x4*)((isv ? CVb : CKb) + e) = pack8(a, b);
        }
        SPLIT_WAIT(0);
        {
            LAS float* Al = ldsf; LAS float* red = ldsf + NCOND * 1024;
            for (int it = (bid + G - 96 % G) % G; it < DEPTH * 65; it += G) {
                const int l = it / 65, j = it % 65; const bool isA = j < 21;
                const int soff = isA ? 0 : 3 * 1024;
                for (int o = tid; o < NCOND * 1024; o += 512) { const int c = o >> 10, k = o & 1023; Al[o] = mods[((size_t)l * NCOND + c) * 6144 + soff + k]; }
                __syncthreads();
                if (isA) { if (j * 128 + 128 <= IN_W) smallm_item_dma(lds, INP(I_WIN) + (size_t)l * DM * IN_W, IN_W, j * 128, nullptr, cva + (size_t)l * NCOND * IN_WP, IN_WP);
                           else smallm_item(Al, red, INP(I_WIN) + (size_t)l * DM * IN_W, IN_W, j * 128, IN_W, nullptr, cva + (size_t)l * NCOND * IN_WP, IN_WP); }
                else smallm_item_dma(lds, INP(I_WFFI) + (size_t)l * DM * FF2, FF2, (j - 21) * 128, nullptr, cvd + (size_t)l * NCOND * FF2, FF2);
            }
            __syncthreads();
        }
        for (int o = bid * 512 + tid; o < DEPTH * 2 * NCOND * DM; o += G * 512) {
            const int col = o & 1023, c = (o >> 10) % NCOND, j = (o / (NCOND * DM)) & 1, l = o / (2 * NCOND * DM);
            const float gn = (j ? INP(I_G2) : INP(I_G1))[l * DM + col];
            wsc[o] = gn * (1.0f + mods[((size_t)l * NCOND + c) * 6144 + (j ? 4 : 1) * 1024 + col]);
        }
        for (int r0 = gw * 4; r0 < M; r0 += NGW * 4) {
            const float* g1 = INP(I_G1);
            f32x4 v[4][4]; const float* scp[4];
#pragma unroll
            for (int q = 0; q < 4; ++q) { const int r = r0 + q;
                const float* src = (r < M_CTX) ? INP(I_XP) + (size_t)r * DM : INP(I_XS) + (size_t)(r - M_CTX) * DM;
                const int ci = (r < M_CTX) ? 8 : ((r - M_CTX) >> 12); scp[q] = mods + (size_t)ci * 6144 + 1024;
#pragma unroll
                for (int j = 0; j < 4; ++j) v[q][j] = *(const f32x4*)(src + 4 * lane + 256 * j); }
#pragma unroll
            for (int q = 0; q < 4; ++q) { const int r = r0 + q; float ss = 0.f;
#pragma unroll
                for (int j = 0; j < 4; ++j) ss += (v[q][j][0] * v[q][j][0] + v[q][j][1] * v[q][j][1]) + (v[q][j][2] * v[q][j][2] + v[q][j][3] * v[q][j][3]);
                ss = wave_sum(ss);
                if (lane == 0) rowss[r] = ss;
#pragma unroll
                for (int j = 0; j < 4; ++j) { const int col = 4 * lane + 256 * j; const f32x4 s4 = *(const f32x4*)(scp[q] + col), g4 = *(const f32x4*)(g1 + col);
                    const f32x4 a = v[q][j] * g4 * (s4 + 1.0f); u32x2 w; w.x = cvt_pk_bf16(a[0], a[1]); w.y = cvt_pk_bf16(a[2], a[3]); *(u32x2*)(XA + (size_t)r * DM + col) = w; } }
        }
    }
    SEAM(1);

    for (int l = 0; l < DEPTH; ++l) {
        const int P = 2 + 7 * l;
        for (int rep_ = 1 + ((REPEAT_MASK >> 2) & 1); rep_ > 0 && IN_PH(P + 0); --rep_) { WSL
            pg8::Gemm g{XA, Win_t + (size_t)l * IN_WP * DM, M, IN_WP, DM}; pg8::StaticOrder S; S.init(M, IN_WP, G, bid, 1);
            EpiA E{l, wsl, outl, INP(I_QG) + l * 64, INP(I_KG) + l * 64};
            pg8::gemm_phase<EpiA, pg8::StaticOrder>(lds, g, S, E, tid);
            { pg8::Unit su; if (S.sub4(0, su)) { int t2_ = tid; asm volatile("" : "+v"(t2_)); pg8::gemm_sub4<EpiA>(lds, g, su, E, t2_); } }
        }
        SEAM(P + 0);
        LAS float* g_laf = ldsf;
        LAS float* g_lab = ldsf + 2048;
        LAS float* g_qf = ldsf + 4096;
        LAS float* g_kf = g_qf + 2112;
        LAS float* g_qb = g_kf + 2112;
        LAS float* g_kb = g_qb + 2112;
        LAS float* g_v = g_kb + 2112;
        LAS float* g_A = g_v + 4096;
        LAS float* g_sf = g_A + 4160;
        LAS float* g_sb = g_sf + 2048;
#define GLA_PREP(cidx, h) do { \
            const int row0_ = (cidx) * 64; \
            for (int idx = tid; idx < 4096; idx += 512) { const int dir = idx >> 11, t = (idx >> 5) & 63, d = idx & 31, col = (h) * 32 + d; \
                const float* wg = (dir ? INP(I_WGB) : INP(I_WGF)) + l * 16 * 128; float x = (dir ? INP(I_BGB) : INP(I_BGF))[l * 128 + col]; \
                const float* lr = LR + (size_t)(row0_ + t) * 32 + dir * 16; \
                _Pragma("unroll") for (int r = 0; r < 16; ++r) x += lr[r] * wg[r * 128 + col]; \
                const float ls = fminf(x, 0.f) - __logf(1.0f + __expf(-fabsf(x))); \
                (dir ? g_lab : g_laf)[t * 32 + d] = ls * (1.0f / 16.0f); } \
            __syncthreads(); \
            if (tid < 64) { const int d = tid & 31; float run = 0.f; \
                if (tid < 32) { for (int t = 0; t < 64; ++t) { run += g_laf[t * 32 + d]; g_laf[t * 32 + d] = run; } } \
                else { for (int t = 63; t >= 0; --t) { run += g_lab[t * 32 + d]; g_lab[t * 32 + d] = run; } } } \
            __syncthreads(); \
            for (int idx = tid; idx < 2048; idx += 512) { const int t = idx >> 5, d = idx & 31; \
                const float qv = bf2f(QLK[(size_t)(row0_ + t) * 256 + (h) * 32 + d]), kv = bf2f(QLK[(size_t)(row0_ + t) * 256 + 128 + (h) * 32 + d]); \
                const float bfv = g_laf[t * 32 + d], cbv = g_lab[t * 32 + d]; \
                g_qf[t * 33 + d] = qv * __expf(bfv); g_kf[t * 33 + d] = kv * __expf(-bfv); g_qb[t * 33 + d] = qv * __expf(cbv); g_kb[t * 33 + d] = kv * __expf(-cbv); } \
            for (int idx = tid; idx < 4096; idx += 512) { const int t = idx >> 6, dv = idx & 63; g_v[idx] = bf2f(VL[(size_t)(row0_ + t) * 256 + (h) * 64 + dv]); } \
            __syncthreads(); } while (0)
#if GLA_NAIVE
        for (int rep_ = 1 + ((REPEAT_MASK >> 3) & 1); rep_ > 0 && IN_PH(P + 1); --rep_) { WSL
            for (int it = bid; it < NCHUNK * 4; it += G) {
                const int cidx = it >> 2, h = it & 3;
                GLA_PREP(cidx, h);
                const int dk = tid >> 4, dv0 = (tid & 15) * 4;
                f32x4 af = (f32x4){0.f, 0.f, 0.f, 0.f}, ab = af;
                for (int s = 0; s < 64; ++s) { const float kfv = g_kf[s * 33 + dk], kbv = g_kb[s * 33 + dk]; const f32x4 vv = *(const LAS f32x4*)(g_v + s * 64 + dv0); af += vv * kfv; ab += vv * kbv; }
                const float ef = __expf(g_laf[63 * 32 + dk]), eb = __expf(g_lab[dk]);
                *(f32x4*)(UF + (size_t)it * 2048 + dk * 64 + dv0) = af * ef; *(f32x4*)(UB + (size_t)it * 2048 + dk * 64 + dv0) = ab * eb;
                if ((tid & 15) == 0) { DF[it * 32 + dk] = ef; DB[it * 32 + dk] = eb; }
                __syncthreads();
            }
        }
#else
        for (int rep_ = 1 + ((REPEAT_MASK >> 3) & 1); rep_ > 0 && IN_PH(P + 1); --rep_) { WSL
            const int dir = wave >> 2, h = wave & 3;
            for (int i = tid; i < 2 * 2048; i += 512) ((LAS float*)(lds + 66560))[i] = ((i >> 11) ? INP(I_WGB) : INP(I_WGF))[l * 2048 + (i & 2047)];
            for (int i = tid; i < 2 * 128; i += 512) ((LAS float*)(lds + 82944))[i] = ((i >> 7) ? INP(I_BGB) : INP(I_BGF))[l * 128 + (i & 127)];
            __syncthreads();
            const LAS float* gwl = (const LAS float*)(lds + 66560) + dir * 2048 + h * 32;
            const LAS float* gbl = (const LAS float*)(lds + 82944) + dir * 128 + h * 32;
            LAS unsigned char* kimg = lds + (dir * 4 + h) * 4096;
            LAS unsigned char* vimg = lds + 32768 + h * 8192;
            LAS float* tot = (LAS float*)(lds + 65536) + (dir * 4 + h) * 32;
            const int lane_g1 = lane;
            for (int cidx = (bid + G / 2) % G; cidx < NCHUNK; cidx += G) {
                int lane = lane_g1; asm volatile("" : "+v"(lane));
                const int g = lane >> 4, q4 = (lane & 15) >> 2, p4 = lane & 3;
                const int row0 = cidx * 64, c16 = lane & 15;
                u32x2 qwv[4][2], kwv[4][2]; u32x4 vst[4];
#pragma unroll
                for (int tt = 0; tt < 4; ++tt)
#pragma unroll
                    for (int dt = 0; dt < 2; ++dt) { const int t = 16 * tt + c16, d0 = 16 * dt + 4 * g;
                        qwv[tt][dt] = *(const u32x2*)(QLK + (size_t)(row0 + t) * 256 + h * 32 + d0); kwv[tt][dt] = *(const u32x2*)(QLK + (size_t)(row0 + t) * 256 + 128 + h * 32 + d0); }
                {   const int vrow = 32 * dir + (lane >> 1), part = lane & 1;
                    const u32x4* vp = (const u32x4*)(VL + (size_t)(row0 + vrow) * 256 + h * 64 + part * 32);
#pragma unroll
                    for (int c4 = 0; c4 < 4; ++c4) vst[c4] = vp[c4]; }
                bf16x8 a1[2], a2[2]; f32x4 bia[2];
#pragma unroll
                for (int dt = 0; dt < 2; ++dt) { unsigned hi[4], lo[4];
#pragma unroll
                    for (int j2 = 0; j2 < 4; ++j2) { const float w0 = gwl[(8 * (g & 1) + 2 * j2) * 128 + 16 * dt + c16], w1 = gwl[(8 * (g & 1) + 2 * j2 + 1) * 128 + 16 * dt + c16];
                        hi[j2] = cvt_pk_bf16(w0, w1); lo[j2] = cvt_pk_bf16(w0 - bflo(hi[j2]), w1 - bfhi(hi[j2])); }
                    a1[dt] = __builtin_bit_cast(bf16x8, (u32x4){hi[0], hi[1], hi[2], hi[3]}); a2[dt] = __builtin_bit_cast(bf16x8, (u32x4){lo[0], lo[1], lo[2], lo[3]});
                    bia[dt] = *(const LAS f32x4*)(gbl + 16 * dt + 4 * g); }
                f32x4 xg[4][2];
#pragma unroll
                for (int tt = 0; tt < 4; ++tt) {
                    const f32x4* lp = (const f32x4*)(LR + (size_t)(row0 + 16 * tt + c16) * 32 + dir * 16 + 8 * (g & 1));
                    const f32x4 l0 = lp[0], l1 = lp[1];
                    unsigned hi[4], lo[4];
                    hi[0] = cvt_pk_bf16(l0[0], l0[1]); hi[1] = cvt_pk_bf16(l0[2], l0[3]); hi[2] = cvt_pk_bf16(l1[0], l1[1]); hi[3] = cvt_pk_bf16(l1[2], l1[3]);
                    lo[0] = cvt_pk_bf16(l0[0] - bflo(hi[0]), l0[1] - bfhi(hi[0])); lo[1] = cvt_pk_bf16(l0[2] - bflo(hi[1]), l0[3] - bfhi(hi[1]));
                    lo[2] = cvt_pk_bf16(l1[0] - bflo(hi[2]), l1[1] - bfhi(hi[2])); lo[3] = cvt_pk_bf16(l1[2] - bflo(hi[3]), l1[3] - bfhi(hi[3]));
                    const bool uh = g < 2;
                    const bf16x8 bfr = __builtin_bit_cast(bf16x8, (u32x4){uh ? hi[0] : lo[0], uh ? hi[1] : lo[1], uh ? hi[2] : lo[2], uh ? hi[3] : lo[3]});
#pragma unroll
                    for (int dt = 0; dt < 2; ++dt) { f32x4 acc = __builtin_amdgcn_mfma_f32_16x16x32_bf16(a1[dt], bfr, bia[dt], 0, 0, 0);
                        xg[tt][dt] = __builtin_amdgcn_mfma_f32_16x16x32_bf16(a2[dt], bfr, acc, 0, 0, 0); }
                }
#pragma unroll
                for (int tt = 0; tt < 4; ++tt)
#pragma unroll
                    for (int dt = 0; dt < 2; ++dt)
#pragma unroll
                        for (int i = 0; i < 4; ++i) { const float x = xg[tt][dt][i]; xg[tt][dt][i] = (fminf(x, 0.f) - __logf(1.0f + __expf(-fabsf(x)))) * (1.0f / 16.0f); }
#pragma unroll
                for (int dt = 0; dt < 2; ++dt)
#pragma unroll
                    for (int i = 0; i < 4; ++i) {
                        float carry = 0.f;
#pragma unroll
                        for (int tq = 0; tq < 4; ++tq) { const int tt = dir ? 3 - tq : tq;
                            float v = xg[tt][dt][i], tot = v;
                            if (dir == 0) { v += dpp0<0x111>(v); v += dpp0<0x112>(v); v += dpp0<0x114>(v); v += dpp0<0x118>(v); }
                            else { v += dpp0<0x101>(v); v += dpp0<0x102>(v); v += dpp0<0x104>(v); v += dpp0<0x108>(v); }
                            tot += dpp0<0x128>(tot); tot += dpp0<0x124>(tot); tot += dpp0<0x122>(tot); tot += dpp0<0x121>(tot);
                            xg[tt][dt][i] = v + carry; carry += tot; }
                        if (c16 == 0) tot[16 * dt + 4 * g + i] = carry;
                    }
                bf16* qo = QKT + (size_t)row0 * 512 + dir * 256 + h * 32; bf16* ko = qo + 128;
#pragma unroll
                for (int tt = 0; tt < 4; ++tt)
#pragma unroll
                    for (int dt = 0; dt < 2; ++dt) {
                        const int t = 16 * tt + c16, d0 = 16 * dt + 4 * g;
                        const u32x2 qw = qwv[tt][dt], kw = kwv[tt][dt];
                        float e[4], en[4];
#pragma unroll
                        for (int i = 0; i < 4; ++i) { e[i] = __expf(xg[tt][dt][i]); en[i] = __expf(-xg[tt][dt][i]); }
                        u32x2 qv, kv;
                        qv.x = cvt_pk_bf16(bflo(qw.x) * e[0], bfhi(qw.x) * e[1]); qv.y = cvt_pk_bf16(bflo(qw.y) * e[2], bfhi(qw.y) * e[3]);
                        kv.x = cvt_pk_bf16(bflo(kw.x) * en[0], bfhi(kw.x) * en[1]); kv.y = cvt_pk_bf16(bflo(kw.y) * en[2], bfhi(kw.y) * en[3]);
                        *(u32x2*)(qo + (size_t)t * 512 + d0) = qv; *(u32x2*)(ko + (size_t)t * 512 + d0) = kv;
                        *(LAS u32x2*)(kimg + off64(t, 2 * dt + (g >> 1)) + 8 * (g & 1)) = kv;
                    }
                {
                    const int vrow = 32 * dir + (lane >> 1), part = lane & 1;
#pragma unroll
                    for (int c4 = 0; c4 < 4; ++c4) *(LAS u32x4*)(vimg + na_off(vrow, part * 4 + c4)) = vst[c4];
                }
                __syncthreads();
                f32x4 u[2][4];
#pragma unroll
                for (int a = 0; a < 2; ++a)
#pragma unroll
                    for (int b = 0; b < 4; ++b) u[a][b] = (f32x4){0.f, 0.f, 0.f, 0.f};
#pragma unroll
                for (int ks = 0; ks < 2; ++ks) {
                    const int tr0 = 32 * ks + 8 * g + q4, tr1 = tr0 + 4;
                    bf16x8 af[2], bfv[4];
#pragma unroll
                    for (int dkt = 0; dkt < 2; ++dkt) { const s16x4 lo = na_tr(kimg + off64(tr0, 2 * dkt + (p4 >> 1)) + 8 * (p4 & 1)), hi = na_tr(kimg + off64(tr1, 2 * dkt + (p4 >> 1)) + 8 * (p4 & 1));
                        af[dkt] = (bf16x8){lo[0], lo[1], lo[2], lo[3], hi[0], hi[1], hi[2], hi[3]}; }
#pragma unroll
                    for (int dvt = 0; dvt < 4; ++dvt) { const s16x4 lo = na_tr(vimg + na_off(tr0, 2 * dvt + (p4 >> 1)) + 8 * (p4 & 1)), hi = na_tr(vimg + na_off(tr1, 2 * dvt + (p4 >> 1)) + 8 * (p4 & 1));
                        bfv[dvt] = (bf16x8){lo[0], lo[1], lo[2], lo[3], hi[0], hi[1], hi[2], hi[3]}; }
#pragma unroll
                    for (int dkt = 0; dkt < 2; ++dkt)
#pragma unroll
                        for (int dvt = 0; dvt < 4; ++dvt) u[dkt][dvt] = __builtin_amdgcn_mfma_f32_16x16x32_bf16(bfv[dvt], af[dkt], u[dkt][dvt], 0, 0, 0);
                }
                {   const size_t item = (size_t)cidx * 4 + h; float* Uo = (dir ? UB : UF) + item * 2048; float* Do = (dir ? DB : DF) + item * 32;
#pragma unroll
                    for (int dkt = 0; dkt < 2; ++dkt) { const int dk = 16 * dkt + (lane & 15); const float ef = __expf(tot[dk]);
#pragma unroll
                        for (int dvt = 0; dvt < 4; ++dvt) *(f32x4*)(Uo + dk * 64 + 16 * dvt + 4 * g) = u[dkt][dvt] * ef;
                        if (g == 0) Do[dk] = ef; }
                }
                __syncthreads();
            }
        }
#endif
        SPLIT_ARRIVE(P + 1);
        for (int rep_ = 1 + ((REPEAT_MASK >> 3) & 1); rep_ > 0 && IN_PH(P + 1); --rep_) { WSL
#if POOL_NAIVE
            {
                LAS float* dbuf = ldsf;
                const float* wp = INP(I_WPOOL) + (size_t)l * 4 * 64 * 64; const float* psc = INP(I_PSCALE) + l * 256;
                for (int it = bid; it < M / 32; it += G) {
                    const int row0 = it * 32;
                    int seq0, L; if (row0 < M_CTX) { seq0 = row0 & ~255; L = 256; } else { seq0 = M_CTX + ((row0 - M_CTX) & ~4095); L = 4096; }
                    {   const int c = tid & 255, half = tid >> 8, g = c >> 6, hw = 1 << g;
                        for (int tt = half * 16; tt < half * 16 + 16; ++tt) {
                            const int t = row0 + tt - seq0; const int a = max(t - hw, 0), b = min(t + hw, L);
                            float s = 0.f; for (int q = a; q < b; ++q) s += bf2f(Ub[(size_t)(seq0 + q) * 256 + c]);
                            dbuf[tt * 256 + c] = s / (float)(b - a) - bf2f(Ub[(size_t)(row0 + tt) * 256 + c]);
                        } }
                    __syncthreads();
                    {   const int oc = tid & 255, g = oc >> 6, dd = oc & 63, th = tid >> 8;
                        float acc[16];
#pragma unroll
                        for (int j = 0; j < 16; ++j) acc[j] = 0.f;
                        for (int c = 0; c < 64; ++c) { const float w = wp[(g * 64 + c) * 64 + dd];
#pragma unroll
                            for (int j = 0; j < 16; ++j) acc[j] += dbuf[(th + 2 * j) * 256 + g * 64 + c] * w; }
                        const float sc = psc[oc];
#pragma unroll
                        for (int j = 0; j < 16; ++j) Y[(size_t)(row0 + th + 2 * j) * DM + oc] = (bf16)(cvt_pk_bf16(acc[j] * sc, 0.f) & 0xffffu);
                    }
                    __syncthreads();
                }
            }
#else
            {
                const bf16* WPTl = WPT + (size_t)l * 4 * 64 * 64; const float* psc = INP(I_PSCALE) + l * 256;
                LAS unsigned char* dimg = lds + 40960;
                const int tid_pl = tid;
#define POOL_DMA(it_, buf_) do { const int row0_ = (it_) * 64; int seq0_, L_; if (row0_ < M_CTX) { seq0_ = row0_ & ~255; L_ = 256; } else { seq0_ = M_CTX + ((row0_ - M_CTX) & ~4095); L_ = 4096; } \
                    int tf_ = tid_pl; asm volatile("" : "+v"(tf_)); \
                    _Pragma("unroll") for (int j_ = 0; j_ < 5; ++j_) { const int idx_ = tf_ + 512 * j_, rowl_ = idx_ >> 5, ch_ = idx_ & 31, ts_ = min(max(row0_ - seq0_ - 8 + rowl_, 0), L_ - 1); \
                        __builtin_amdgcn_global_load_lds((const unsigned*)(Ub + (size_t)(seq0_ + ts_) * 256 + ch_ * 8), (LAS unsigned*)(lds + (buf_) + (j_ * 512 + wave * 64) * 16), 16, 0, 0); } } while (0)
                int pbuf = 0;
                if (bid < NCHUNK) POOL_DMA(bid, 0);
                for (int it = bid; it < NCHUNK; it += G) {
                    int tid = tid_pl; asm volatile("" : "+v"(tid)); const int lane = tid & 63, g = lane >> 4;
                    const int row0 = it * 64;
                    int seq0, L; if (row0 < M_CTX) { seq0 = row0 & ~255; L = 256; } else { seq0 = M_CTX + ((row0 - M_CTX) & ~4095); L = 4096; }
                    const int tpos0 = row0 - seq0;
                    LAS unsigned char* ubuf = lds + pbuf;
                    asm volatile("s_waitcnt vmcnt(0)" ::: "memory");
                    __syncthreads();
                    if (tpos0 == 0 || tpos0 + 64 == L) {
                        for (int idx = tid; idx < 8 * 32; idx += 512) { const int rowl = (tpos0 == 0 ? 0 : 72) + (idx >> 5), ch = idx & 31; *(LAS u32x4*)(ubuf + rowl * 512 + ch * 16) = (u32x4){0u, 0u, 0u, 0u}; }
                        __syncthreads();
                    }
                    if (it + G < NCHUNK) POOL_DMA(it + G, pbuf ? 0 : 73728);
                    {   const int c = tid & 255, thalf = tid >> 8, grp = c >> 6, hw = 1 << grp;
                        const LAS bf16* uc = (const LAS bf16*)ubuf + c;
                        const int t0 = 32 * thalf;
                        float s = 0.f;
                        for (int j = -hw; j < hw; ++j) s += bf2f(uc[(t0 + 8 + j) * 256]);
                        for (int t = t0; t < t0 + 32; ++t) {
                            const int tp = tpos0 + t; const int cnt = min(tp + hw, L) - max(tp - hw, 0);
                            const float uv = bf2f(uc[(t + 8) * 256]);
                            const float d = s * __builtin_amdgcn_rcpf((float)cnt) - uv;
                            *(LAS bf16*)(dimg + doff(t, c >> 3) + (c & 7) * 2) = (bf16)(cvt_pk_bf16(d, 0.f) & 0xffffu);
                            s += bf2f(uc[(t + 8 + hw) * 256]) - bf2f(uc[(t + 8 - hw) * 256]);
                        } }
                    __syncthreads();
                    {   const int grp = wave >> 1, thh = wave & 1;
#pragma unroll
                        for (int ttl = 0; ttl < 2; ++ttl) {
                            const int trow = 16 * (2 * thh + ttl) + (lane & 15);
                            bf16x8 bfr[2];
#pragma unroll
                            for (int ks = 0; ks < 2; ++ks) bfr[ks] = *(const LAS bf16x8*)(dimg + doff(trow, 8 * grp + 4 * ks + g));
#pragma unroll
                            for (int ddt = 0; ddt < 4; ++ddt) {
                                f32x4 acc = (f32x4){0.f, 0.f, 0.f, 0.f};
#pragma unroll
                                for (int ks = 0; ks < 2; ++ks) { const bf16x8 a = *(const bf16x8*)(WPTl + (size_t)(grp * 64 + 16 * ddt + (lane & 15)) * 64 + 32 * ks + 8 * g);
                                    acc = __builtin_amdgcn_mfma_f32_16x16x32_bf16(a, bfr[ks], acc, 0, 0, 0); }
                                const int dd = grp * 64 + 16 * ddt + 4 * g;
                                const f32x4 sc = *(const f32x4*)(psc + dd);
                                u32x2 w; w.x = cvt_pk_bf16(acc[0] * sc[0], acc[1] * sc[1]); w.y = cvt_pk_bf16(acc[2] * sc[2], acc[3] * sc[3]);
                                *(u32x2*)(Y + (size_t)(row0 + trow) * DM + dd) = w;
                            }
                        } }
                    pbuf = pbuf ? 0 : 73728;
                }
                asm volatile("s_waitcnt vmcnt(0)" ::: "memory");
                __syncthreads();
#undef POOL_DMA
            }
#endif
        }
        SPLIT_WAIT(P + 1);
        for (int rep_ = 1 + ((REPEAT_MASK >> 4) & 1); rep_ > 0 && IN_PH(P + 2); --rep_) { WSL
            for (int it = (bid + G - G / 4) % G; it < 24 * 4 * 2; it += G) {
                const int dir = it & 1, h = (it >> 1) & 3, seq = it >> 3;
                const int e = tid * 4, dk = tid >> 4;
                int chunk0, N; f32x4 S = (f32x4){0.f, 0.f, 0.f, 0.f};
                if (seq < 16) { chunk0 = seq * 4; N = 4; }
                else { const int b = seq - 16; chunk0 = 64 + b * 64; N = 64; S = *(const f32x4*)((dir ? INP(I_SB) : INP(I_SF)) + (size_t)((b * 2 + l) * 4 + h) * 2048 + e); }
                const float* Uu = dir ? UB : UF; const float* Dd = dir ? DB : DF; float* Si = dir ? SINB : SINF; (void)Si;
#if GLA_NAIVE
#define SCAN_STORE(itx_) *(f32x4*)(Si + (itx_) * 2048 + e) = S
#else
#define SCAN_STORE(itx_) do { u32x2 w_; w_.x = cvt_pk_bf16(S[0], S[1]); w_.y = cvt_pk_bf16(S[2], S[3]); *(u32x2*)((dir ? STB : STF) + (itx_) * 2048 + e) = w_; } while (0)
#endif
#define SCAN_BLOCK(NB) do { f32x4 ub_[NB]; float db_[NB]; \
                    _Pragma("unroll") for (int j = 0; j < NB; ++j) { const int ch = dir ? (chunk0 + N - 1 - (n0 + j)) : (chunk0 + n0 + j); const size_t itx = (size_t)ch * 4 + h; db_[j] = Dd[itx * 32 + dk]; ub_[j] = *(const f32x4*)(Uu + itx * 2048 + e); } \
                    _Pragma("unroll") for (int j = 0; j < NB; ++j) { const int ch = dir ? (chunk0 + N - 1 - (n0 + j)) : (chunk0 + n0 + j); const size_t itx = (size_t)ch * 4 + h; SCAN_STORE(itx); S = S * db_[j] + ub_[j]; } } while (0)
                if (N == 4) { const int n0 = 0; SCAN_BLOCK(4); }
                else {
#pragma unroll 1
                    for (int n0 = 0; n0 < N; n0 += 16) { SCAN_BLOCK(16); }
                }
#undef SCAN_BLOCK
#undef SCAN_STORE
                if (seq < 16) *(f32x4*)(outl + (dir ? OUT_GB : OUT_GF) + (size_t)((seq * 2 + l) * 4 + h) * 2048 + e) = S;
            }
        }
        SPLIT_ARRIVE(P + 2);
        for (int rep_ = 1 + ((REPEAT_MASK >> 10) & 1); rep_ > 0 && IN_PH(P + 3); --rep_) { WSL
#if NA_NAIVE
            for (int it = bid; it < 128 + 1024; it += G) {
                const int half = tid & 1, qi = tid >> 1;
                float q[32], o[32]; float mx = -INFINITY, ls = 0.f;
#pragma unroll
                for (int d = 0; d < 32; ++d) o[d] = 0.f;
                int rowq, h;
#define NA_KEY(kp_is_f32, kptr, vptr, sbias) do { \
                    float s_ = 0.f; \
                    if (kp_is_f32) { const f32x4* k4 = (const f32x4*)((const float*)(kptr) + 32 * half); _Pragma("unroll") for (int d4 = 0; d4 < 8; ++d4) { const f32x4 kk = k4[d4]; s_ += q[4 * d4] * kk[0] + q[4 * d4 + 1] * kk[1] + q[4 * d4 + 2] * kk[2] + q[4 * d4 + 3] * kk[3]; } } \
                    else { const u32x4* k8 = (const u32x4*)((const bf16*)(kptr) + 32 * half); _Pragma("unroll") for (int d8 = 0; d8 < 4; ++d8) { const u32x4 kk = k8[d8]; \
                        s_ += q[8 * d8] * bflo(kk.x) + q[8 * d8 + 1] * bfhi(kk.x) + q[8 * d8 + 2] * bflo(kk.y) + q[8 * d8 + 3] * bfhi(kk.y) + q[8 * d8 + 4] * bflo(kk.z) + q[8 * d8 + 5] * bfhi(kk.z) + q[8 * d8 + 6] * bflo(kk.w) + q[8 * d8 + 7] * bfhi(kk.w); } } \
                    s_ += __shfl_xor(s_, 1); s_ += (sbias); \
                    const float mn_ = fmaxf(mx, s_); const float al_ = __builtin_amdgcn_exp2f(mx - mn_), p_ = __builtin_amdgcn_exp2f(s_ - mn_); mx = mn_; ls = ls * al_ + p_; \
                    if (kp_is_f32) { const f32x4* v4 = (const f32x4*)((const float*)(vptr) + 32 * half); _Pragma("unroll") for (int d4 = 0; d4 < 8; ++d4) { const f32x4 vv = v4[d4]; o[4 * d4] = o[4 * d4] * al_ + p_ * vv[0]; o[4 * d4 + 1] = o[4 * d4 + 1] * al_ + p_ * vv[1]; o[4 * d4 + 2] = o[4 * d4 + 2] * al_ + p_ * vv[2]; o[4 * d4 + 3] = o[4 * d4 + 3] * al_ + p_ * vv[3]; } } \
                    else { const u32x4* v8 = (const u32x4*)((const bf16*)(vptr) + 32 * half); _Pragma("unroll") for (int d8 = 0; d8 < 4; ++d8) { const u32x4 vv = v8[d8]; \
                        o[8 * d8] = o[8 * d8] * al_ + p_ * bflo(vv.x); o[8 * d8 + 1] = o[8 * d8 + 1] * al_ + p_ * bfhi(vv.x); o[8 * d8 + 2] = o[8 * d8 + 2] * al_ + p_ * bflo(vv.y); o[8 * d8 + 3] = o[8 * d8 + 3] * al_ + p_ * bfhi(vv.y); \
                        o[8 * d8 + 4] = o[8 * d8 + 4] * al_ + p_ * bflo(vv.z); o[8 * d8 + 5] = o[8 * d8 + 5] * al_ + p_ * bfhi(vv.z); o[8 * d8 + 6] = o[8 * d8 + 6] * al_ + p_ * bflo(vv.w); o[8 * d8 + 7] = o[8 * d8 + 7] * al_ + p_ * bfhi(vv.w); } } \
                } while (0)
#define NA_LOADQ() do { const u32x4* q8 = (const u32x4*)(Qb + (size_t)rowq * 512 + h * 64 + 32 * half); \
                    _Pragma("unroll") for (int d8 = 0; d8 < 4; ++d8) { const u32x4 w_ = q8[d8]; q[8 * d8] = bflo(w_.x); q[8 * d8 + 1] = bfhi(w_.x); q[8 * d8 + 2] = bflo(w_.y); q[8 * d8 + 3] = bfhi(w_.y); q[8 * d8 + 4] = bflo(w_.z); q[8 * d8 + 5] = bfhi(w_.z); q[8 * d8 + 6] = bflo(w_.w); q[8 * d8 + 7] = bfhi(w_.w); } } while (0)
                if (it < 128) {
                    const int b = it >> 3; h = it & 7; rowq = b * 256 + qi;
                    NA_LOADQ();
                    for (int j = 0; j < 256; ++j) { const size_t kr = (size_t)(b * 256 + j) * 512 + h * 64; NA_KEY(false, Kb + kr, Vb + kr, 0.f); }
                } else {
                    const int u = it - 128, b = u >> 7; h = (u >> 4) & 7; const int R4 = u & 15;
                    const int r = R4 * 4 + (qi >> 6), c = qi & 63; rowq = M_CTX + b * 4096 + r * 64 + c;
                    NA_LOADQ();
                    const int rs0 = min(max(r - 4, 0), 56), cs0 = min(max(c - 8, 0), 48);
                    const float* rb = INP(I_RELB) + (size_t)(l * 8 + h) * 15 * 31;
                    for (int i = 0; i < 8; ++i) { const int kr_ = rs0 + i;
                        for (int kc = 0; kc < 64; ++kc) {
                            if (kc >= cs0 && kc < cs0 + 16) {
                                const size_t kr = (size_t)(M_CTX + b * 4096 + kr_ * 64 + kc) * 512 + h * 64;
                                const float bias = rb[(kr_ - r + 7) * 31 + (kc - c + 15)] * LOG2E;
                                NA_KEY(false, Kb + kr, Vb + kr, bias);
                            } } }
                    const float* ck = INP(I_CK) + (size_t)((b * 2 + l) * 8 + h) * 512 * 64; const float* cvp = INP(I_CV) + (size_t)((b * 2 + l) * 8 + h) * 512 * 64;
                    for (int n = 0; n < 512; ++n) { NA_KEY(true, ck + (size_t)n * 64, cvp + (size_t)n * 64, 0.f); }
                }
                const float inv = 1.0f / ls;
                u32x4* yo = (u32x4*)(Y + (size_t)rowq * DM + 256 + h * 64 + 32 * half);
#pragma unroll
                for (int d8 = 0; d8 < 4; ++d8) { u32x4 w; w.x = cvt_pk_bf16(o[8 * d8] * inv, o[8 * d8 + 1] * inv); w.y = cvt_pk_bf16(o[8 * d8 + 2] * inv, o[8 * d8 + 3] * inv); w.z = cvt_pk_bf16(o[8 * d8 + 4] * inv, o[8 * d8 + 5] * inv); w.w = cvt_pk_bf16(o[8 * d8 + 6] * inv, o[8 * d8 + 7] * inv); yo[d8] = w; }
#undef NA_KEY
#undef NA_LOADQ
            }
#else
            {
                LAS unsigned char* nl = lds;
                LAS float* btab = (LAS float*)(lds + 32768);
                const int vcu = (bid & 7) * (G >> 3) + (bid >> 3);
                const int tid_na = tid;
                int h_tab = -1;
                if (wave >= 4) __builtin_amdgcn_s_setprio(1);
                for (int it0 = 0; it0 < 1280; it0 += G) {
                    int tid = tid_na; asm volatile("" : "+v"(tid)); const int lane = tid & 63;
                    const int g = lane >> 4, qc = lane & 15;
                    const int srow = tid >> 3, sch = tid & 7;
                    const int sdst = na_off(srow, sch);
                    const int it = it0 + ((G & 7) == 0 ? vcu : bid);
                    if (it >= 1280) break;
                    const bool lat = it < 1024;
                    int b, h, r0 = 0, half = 0;
                    if (lat) { b = it >> 7; h = (it >> 4) & 7; r0 = (it & 15) * 4; } else { const int u = it - 1024; b = u >> 4; h = (u >> 1) & 7; half = u & 1; }
                    const int lo = lat ? min(max(r0 - 4, 0), 56) : 0, hi = lat ? (min(max(r0 - 1, 0), 56) + 8) : 0;
                    const int nctx = lat ? 8 : 4, ntile = nctx + (hi - lo);
                    const bf16* kc_base; const bf16* vc_base; int cpitch;
                    if (lat) { kc_base = CKb + (size_t)((b * 2 + l) * 8 + h) * 512 * 64; vc_base = CVb + (size_t)((b * 2 + l) * 8 + h) * 512 * 64; cpitch = 64; }
                    else { kc_base = Kb + (size_t)(b * 256) * 512 + h * 64; vc_base = Vb + (size_t)(b * 256) * 512 + h * 64; cpitch = 512; }
                    const bf16* kl_base = Kb + (size_t)(M_CTX + b * 4096) * 512 + h * 64; const bf16* vl_base = Vb + (size_t)(M_CTX + b * 4096) * 512 + h * 64;
#define NA_TILE_SRC(t, kp, vp) do { if ((t) < nctx) { const size_t o_ = (size_t)((t) * 64 + srow) * cpitch + sch * 8; kp = kc_base + o_; vp = vc_base + o_; } \
                                    else { const size_t o_ = (size_t)((lo + (t) - nctx) * 64 + srow) * 512 + sch * 8; kp = kl_base + o_; vp = vl_base + o_; } } while (0)
                    u32x4 kreg, vreg;
                    { const bf16* kp; const bf16* vp; NA_TILE_SRC(0, kp, vp); kreg = *(const u32x4*)kp; vreg = *(const u32x4*)vp; }
                    const int pair = wave >> 2, jb = wave & 3;
                    int rowq[2]; int rq[2];
                    if (lat) { rq[0] = r0 + 2 * pair; rq[1] = rq[0] + 1; rowq[0] = M_CTX + b * 4096 + rq[0] * 64 + 16 * jb + qc; rowq[1] = rowq[0] + 64; }
                    else { rq[0] = rq[1] = 0; rowq[0] = b * 256 + half * 128 + wave * 16 + qc; rowq[1] = rowq[0]; }
                    bf16x8 qf[2][2];
#pragma unroll
                    for (int qb = 0; qb < 2; ++qb)
#pragma unroll
                        for (int s = 0; s < 2; ++s) qf[qb][s] = *(const bf16x8*)(Qb + (size_t)rowq[qb] * 512 + h * 64 + 32 * s + 8 * g);
                    f32x4 cinv[2]; cinv[0] = (f32x4){0.f, 0.f, 0.f, 0.f}; cinv[1] = cinv[0];
                    f32x4 o[2][4], osum[2]; osum[0] = (f32x4){0.f, 0.f, 0.f, 0.f}; osum[1] = osum[0];
                    const bf16x8 ones = (bf16x8){(short)0x3F80, (short)0x3F80, (short)0x3F80, (short)0x3F80, (short)0x3F80, (short)0x3F80, (short)0x3F80, (short)0x3F80};
#pragma unroll
                    for (int qb = 0; qb < 2; ++qb)
#pragma unroll
                        for (int c = 0; c < 4; ++c) o[qb][c] = (f32x4){0.f, 0.f, 0.f, 0.f};
                    if (lat && h != h_tab) { h_tab = h; const float* rb = INP(I_RELB) + (size_t)(l * 8 + h) * 465;
                        for (int i = tid; i < 15 * 64; i += 512) { const int dr = i >> 6, x = (i & 63) - 16; btab[i] = (x >= 0 && x < 31) ? rb[dr * 31 + x] * LOG2E : 0.f; } }
                    *(LAS u32x4*)(nl + sdst) = kreg; *(LAS u32x4*)(nl + 8192 + sdst) = vreg;
                    if (1 < ntile) { const bf16* kp; const bf16* vp; NA_TILE_SRC(1, kp, vp); kreg = *(const u32x4*)kp; vreg = *(const u32x4*)vp; }
                    __syncthreads();
                    const int cq = 16 * jb + qc, cs0 = min(max(cq - 8, 0), 48), st = min(max(16 * jb - 8, 0), 32);
                    f32x4 maskc[2];
#pragma unroll
                    for (int tt = 0; tt < 2; ++tt)
#pragma unroll
                        for (int i = 0; i < 4; ++i) { const int kc = st + 16 * tt + 4 * g + i; maskc[tt][i] = ((kc >= cs0) && (kc < cs0 + 16)) ? 0.f : -INFINITY; }
                    f32x4 mk[2][2]; mk[0][0] = maskc[0]; mk[0][1] = maskc[1]; mk[1][0] = maskc[0]; mk[1][1] = maskc[1];
                    auto na_tiles = [&](auto latc_) __attribute__((always_inline)) {
                    constexpr bool LT = decltype(latc_)::value;
                    for (int t = 0; t < nctx; ++t) {
                        LAS unsigned char* kb = nl + (t & 1) * 16384; LAS unsigned char* vb = kb + 8192;
                        {
                            bf16x8 pf1d, vfd[4];
#pragma unroll
                            for (int ks = 0; ks < 2; ++ks) {
                                bf16x8 kf[2][2], vf[4];
#pragma unroll
                                for (int kt = 0; kt < 2; ++kt) na_kfrag(kb, 32 * ks + 16 * kt, lane, kf[kt][0], kf[kt][1]);
#pragma unroll
                                for (int c = 0; c < 4; ++c) vf[c] = na_vfrag(vb, 32 * ks, 32 * ks + 16, lane, c);
                                f32x4 s0[2], s1[2];
                                {   const f32x4 c0 = cinv[0], c1 = cinv[1];
#pragma unroll
                                    for (int kt = 0; kt < 2; ++kt) {
                                        s0[kt] = na_qk2(kf[kt][0], kf[kt][1], qf[0][0], qf[0][1], c0);
                                        if (LT) s1[kt] = na_qk2(kf[kt][0], kf[kt][1], qf[1][0], qf[1][1], c1); } }
                                if (!LT) {
                                    bf16x8 pf0[1]; float dl;
                                    na_sm<2>(s0, cinv[0], mk[0], t == 0 && ks == 0, o[0], osum[0], pf0, dl);
#pragma unroll
                                    for (int c = 0; c < 4; ++c) o[0][c] = __builtin_amdgcn_mfma_f32_16x16x32_bf16(vf[c], pf0[0], o[0][c], 0, 0, 0);
                                    osum[0] = __builtin_amdgcn_mfma_f32_16x16x32_bf16(ones, pf0[0], osum[0], 0, 0, 0);
                                } else {
                                    na_sm_pre2(s0, cinv[0], mk[0], t == 0 && ks == 0, o[0], osum[0]);
                                    bf16x8 pf0;
                                    if (ks == 0) {
                                        na_sm_pre2(s1, cinv[1], mk[1], t == 0 && ks == 0, o[1], osum[1]);
#pragma unroll
                                        for (int tt = 0; tt < 2; ++tt)
#pragma unroll
                                            for (int i = 0; i < 4; ++i) s0[tt][i] = __builtin_amdgcn_exp2f(s0[tt][i]);
                                        pf0 = na_pack2(s0);
                                    } else {
                                        __builtin_amdgcn_sched_barrier(0);
#pragma unroll
                                        for (int c = 0; c < 4; ++c) {
                                            o[1][c] = __builtin_amdgcn_mfma_f32_16x16x32_bf16(vfd[c], pf1d, o[1][c], 0, 0, 0);
                                            s0[c >> 1][2 * (c & 1)] = __builtin_amdgcn_exp2f(s0[c >> 1][2 * (c & 1)]); s0[c >> 1][2 * (c & 1) + 1] = __builtin_amdgcn_exp2f(s0[c >> 1][2 * (c & 1) + 1]);
                                            __builtin_amdgcn_sched_barrier(0);
                                        }
                                        osum[1] = __builtin_amdgcn_mfma_f32_16x16x32_bf16(ones, pf1d, osum[1], 0, 0, 0);
                                        pf0 = na_pack2(s0);
                                        __builtin_amdgcn_sched_barrier(0);
                                        na_sm_pre2(s1, cinv[1], mk[1], false, o[1], osum[1]);
                                    }
                                    __builtin_amdgcn_sched_barrier(0);
#pragma unroll
                                    for (int c = 0; c < 4; ++c) {
                                        o[0][c] = __builtin_amdgcn_mfma_f32_16x16x32_bf16(vf[c], pf0, o[0][c], 0, 0, 0);
                                        s1[c >> 1][2 * (c & 1)] = __builtin_amdgcn_exp2f(s1[c >> 1][2 * (c & 1)]); s1[c >> 1][2 * (c & 1) + 1] = __builtin_amdgcn_exp2f(s1[c >> 1][2 * (c & 1) + 1]);
                                        __builtin_amdgcn_sched_barrier(0);
                                    }
                                    osum[0] = __builtin_amdgcn_mfma_f32_16x16x32_bf16(ones, pf0, osum[0], 0, 0, 0);
                                    const bf16x8 pf1 = na_pack2(s1);
                                    __builtin_amdgcn_sched_barrier(0);
                                    if (ks == 0) { pf1d = pf1;
#pragma unroll
                                        for (int c = 0; c < 4; ++c) vfd[c] = vf[c];
                                    } else {
#pragma unroll
                                        for (int c = 0; c < 4; ++c) o[1][c] = __builtin_amdgcn_mfma_f32_16x16x32_bf16(vf[c], pf1, o[1][c], 0, 0, 0);
                                        osum[1] = __builtin_amdgcn_mfma_f32_16x16x32_bf16(ones, pf1, osum[1], 0, 0, 0);
                                    }
                                }
                            }
                        }
                        if (t + 1 < ntile) { LAS unsigned char* kn = nl + ((t + 1) & 1) * 16384; *(LAS u32x4*)(kn + sdst) = kreg; *(LAS u32x4*)(kn + 8192 + sdst) = vreg; }
                        if (t + 2 < ntile) { const bf16* kp; const bf16* vp; NA_TILE_SRC(t + 2, kp, vp); kreg = *(const u32x4*)kp; vreg = *(const u32x4*)vp; }
                        __syncthreads();
                    }
                    if (LT) for (int t = nctx; t < ntile; ++t) {
                        LAS unsigned char* kb = nl + (t & 1) * 16384; LAS unsigned char* vb = kb + 8192;
                        {
                            const int kr = lo + t - nctx;
                            const int rsA = min(max(rq[0] - 4, 0), 56), rsB = min(max(rq[1] - 4, 0), 56);
                            const bool actA = kr >= rsA && kr < rsA + 8, actB = kr >= rsB && kr < rsB + 8;
                            if (actA || actB) {
                                bf16x8 kf[2][2], vf[4];
#pragma unroll
                                for (int kt = 0; kt < 2; ++kt) na_kfrag(kb, st + 16 * kt, lane, kf[kt][0], kf[kt][1]);
#pragma unroll
                                for (int c = 0; c < 4; ++c) vf[c] = na_vfrag(vb, st, st + 16, lane, c);
#pragma unroll
                                for (int qb = 0; qb < 2; ++qb) {
                                    if (qb == 0 ? actA : actB) {
                                        const LAS float* brow = btab + (kr - rq[qb] + 7) * 64 + (31 - cq) + st + 4 * g;
                                        f32x4 bz[2];
#pragma unroll
                                        for (int tt = 0; tt < 2; ++tt)
#pragma unroll
                                            for (int i = 0; i < 4; ++i) bz[tt][i] = brow[16 * tt + i];
                                        f32x4 sx[2];
#pragma unroll
                                        for (int tt = 0; tt < 2; ++tt) sx[tt] = na_qk2(kf[tt][0], kf[tt][1], qf[qb][0], qf[qb][1], mk[qb][tt] + bz[tt]);
                                        bf16x8 pf[1]; float dl;
                                        na_sm<2>(sx, cinv[qb], mk[qb], false, o[qb], osum[qb], pf, dl);
#pragma unroll
                                        for (int c = 0; c < 4; ++c) o[qb][c] = __builtin_amdgcn_mfma_f32_16x16x32_bf16(vf[c], pf[0], o[qb][c], 0, 0, 0);
                                        osum[qb] = __builtin_amdgcn_mfma_f32_16x16x32_bf16(ones, pf[0], osum[qb], 0, 0, 0);
                                    }
                                }
                            }
                        }
                        if (t + 1 < ntile) { LAS unsigned char* kn = nl + ((t + 1) & 1) * 16384; *(LAS u32x4*)(kn + sdst) = kreg; *(LAS u32x4*)(kn + 8192 + sdst) = vreg; }
                        if (t + 2 < ntile) { const bf16* kp; const bf16* vp; NA_TILE_SRC(t + 2, kp, vp); kreg = *(const u32x4*)kp; vreg = *(const u32x4*)vp; }
                        __syncthreads();
                    }
                    };
                    if (lat) na_tiles(std::true_type{}); else na_tiles(std::false_type{});
#pragma unroll
                    for (int qb = 0; qb < 2; ++qb) {
                        if (qb == 0 || lat) {
                            const float inv = 1.0f / osum[qb][0];
                            bf16* yo = Y + (size_t)rowq[qb] * DM + 256 + h * 64 + 4 * g;
#pragma unroll
                            for (int c = 0; c < 4; ++c) { u32x2 w; w.x = cvt_pk_bf16(o[qb][c][0] * inv, o[qb][c][1] * inv); w.y = cvt_pk_bf16(o[qb][c][2] * inv, o[qb][c][3] * inv); *(u32x2*)(yo + 16 * c) = w; }
                        }
                    }
                    __syncthreads();
#undef NA_TILE_SRC
                }
                __builtin_amdgcn_s_setprio(0);
            }
#endif
        }
        SPLIT_WAIT(P + 2);
        for (int rep_ = 1 + ((REPEAT_MASK >> 5) & 1); rep_ > 0 && IN_PH(P + 3); --rep_) { WSL
#if GLA_NAIVE
            const float* gg = INP(I_GLAG) + l * 64;
            for (int it = bid; it < NCHUNK * 4; it += G) {
                const int cidx = it >> 2, h = it & 3, row0 = cidx * 64;
                GLA_PREP(cidx, h);
                for (int idx = tid; idx < 2048; idx += 512) { g_sf[idx] = SINF[(size_t)it * 2048 + idx]; g_sb[idx] = SINB[(size_t)it * 2048 + idx]; }
                for (int idx = tid; idx < 4096; idx += 512) { const int t = idx >> 6, s = idx & 63; float a = 0.f;
                    if (s <= t) {
#pragma unroll
                        for (int d = 0; d < 32; ++d) a += g_qf[t * 33 + d] * g_kf[s * 33 + d]; }
                    if (s >= t) {
#pragma unroll
                        for (int d = 0; d < 32; ++d) a += g_qb[t * 33 + d] * g_kb[s * 33 + d]; }
                    g_A[t * 65 + s] = a; }
                __syncthreads();
                {   const int t = tid >> 3, dv0 = (tid & 7) * 8;
                    float acc[8];
#pragma unroll
                    for (int j = 0; j < 8; ++j) acc[j] = 0.f;
                    for (int d = 0; d < 32; ++d) { const float a1 = g_qf[t * 33 + d], a2 = g_qb[t * 33 + d];
#pragma unroll
                        for (int j = 0; j < 8; ++j) acc[j] += a1 * g_sf[d * 64 + dv0 + j] + a2 * g_sb[d * 64 + dv0 + j]; }
                    for (int s = 0; s < 64; ++s) { const float a = g_A[t * 65 + s];
#pragma unroll
                        for (int j = 0; j < 8; ++j) acc[j] += a * g_v[s * 64 + dv0 + j]; }
                    float ss = 0.f;
#pragma unroll
                    for (int j = 0; j < 8; ++j) ss += acc[j] * acc[j];
                    ss += __shfl_xor(ss, 1); ss += __shfl_xor(ss, 2); ss += __shfl_xor(ss, 4);
                    const float rn = rsqrtf(ss * (1.0f / 64.0f) + EPS);
                    const u32x4 gsw = *(const u32x4*)(GS + (size_t)(row0 + t) * 256 + h * 64 + dv0);
                    float o[8];
                    o[0] = acc[0] * rn * gg[dv0 + 0] * bflo(gsw.x); o[1] = acc[1] * rn * gg[dv0 + 1] * bfhi(gsw.x);
                    o[2] = acc[2] * rn * gg[dv0 + 2] * bflo(gsw.y); o[3] = acc[3] * rn * gg[dv0 + 3] * bfhi(gsw.y);
                    o[4] = acc[4] * rn * gg[dv0 + 4] * bflo(gsw.z); o[5] = acc[5] * rn * gg[dv0 + 5] * bfhi(gsw.z);
                    o[6] = acc[6] * rn * gg[dv0 + 6] * bflo(gsw.w); o[7] = acc[7] * rn * gg[dv0 + 7] * bfhi(gsw.w);
                    u32x4 w; w.x = cvt_pk_bf16(o[0], o[1]); w.y = cvt_pk_bf16(o[2], o[3]); w.z = cvt_pk_bf16(o[4], o[5]); w.w = cvt_pk_bf16(o[6], o[7]);
                    *(u32x4*)(Y + (size_t)(row0 + t) * DM + 768 + h * 64 + dv0) = w;
                }
                __syncthreads();
            }
#else
            {
                const float* gg = INP(I_GLAG) + l * 64;
                const int h = wave & 3, th = wave >> 2;
                LAS unsigned char* qfi = lds + (0 * 4 + h) * 4096; LAS unsigned char* kfi = lds + (1 * 4 + h) * 4096;
                LAS unsigned char* qbi = lds + (2 * 4 + h) * 4096; LAS unsigned char* kbi = lds + (3 * 4 + h) * 4096;
                LAS unsigned char* vimg = lds + 65536 + h * 8192;
                const int tid_g3 = tid;
                for (int cidx = (bid + G - G / 4) % G; cidx < NCHUNK; cidx += G) {
                    int tid = tid_g3; asm volatile("" : "+v"(tid)); const int lane = tid & 63, g = lane >> 4;
                    const int row0 = cidx * 64;
                    u32x2 gsv[2][4]; f32x4 gnv[4];
#pragma unroll
                    for (int dvt = 0; dvt < 4; ++dvt) { gnv[dvt] = *(const f32x4*)(gg + 16 * dvt + 4 * g);
#pragma unroll
                        for (int ttl = 0; ttl < 2; ++ttl) gsv[ttl][dvt] = *(const u32x2*)(GS + (size_t)(row0 + 16 * (2 * th + ttl) + (lane & 15)) * 256 + h * 64 + 16 * dvt + 4 * g); }
                    {   const int t = tid >> 3, part = tid & 7;
                        const u32x4* sp = (const u32x4*)(QKT + (size_t)(row0 + t) * 512 + part * 64);
#pragma unroll
                        for (int c8 = 0; c8 < 8; ++c8) { const int cc = part * 8 + c8, a = ((cc >> 5) * 2 + ((cc >> 4) & 1)) * 4 + ((cc >> 2) & 3);
                            *(LAS u32x4*)(lds + a * 4096 + off64(t, cc & 3)) = sp[c8]; }
                        const u32x4* vp = (const u32x4*)(VL + (size_t)(row0 + t) * 256 + part * 32);
#pragma unroll
                        for (int c4 = 0; c4 < 4; ++c4) *(LAS u32x4*)(lds + 65536 + (part >> 1) * 8192 + na_off(t, (part & 1) * 4 + c4)) = vp[c4];
#pragma unroll
                        for (int k4 = 0; k4 < 4; ++k4) { const int idx = tid + 512 * k4, img = idx >> 8, c = idx & 255;
                            const bf16* sp2 = ((img >> 2) ? STB : STF) + ((size_t)cidx * 4 + (img & 3)) * 2048 + c * 8;
                            *(LAS u32x4*)(lds + 98304 + img * 4096 + na_off(c >> 3, c & 7)) = *(const u32x4*)sp2; }
                    }
                    __syncthreads();
#pragma unroll
                    for (int ttl = 0; ttl < 2; ++ttl) {
                        const int tt = 2 * th + ttl, trow = 16 * tt + (lane & 15);
                        const bf16x8 qff = *(const LAS bf16x8*)(qfi + off64(trow, g)), qbf = *(const LAS bf16x8*)(qbi + off64(trow, g));
                        f32x4 at[4];
#pragma unroll
                        for (int st = 0; st < 4; ++st) {
                            const int srow = 16 * st + (lane & 15);
                            const bf16x8 kf = *(const LAS bf16x8*)(kfi + off64(srow, g)), kb = *(const LAS bf16x8*)(kbi + off64(srow, g));
                            const f32x4 z = (f32x4){0.f, 0.f, 0.f, 0.f};
                            const f32x4 df = __builtin_amdgcn_mfma_f32_16x16x32_bf16(kf, qff, z, 0, 0, 0);
                            const f32x4 db = __builtin_amdgcn_mfma_f32_16x16x32_bf16(kb, qbf, z, 0, 0, 0);
#pragma unroll
                            for (int i = 0; i < 4; ++i) { const int sg = 16 * st + 4 * g + i; at[st][i] = (sg <= trow ? df[i] : 0.f) + (sg >= trow ? db[i] : 0.f); }
                        }
                        const bf16x8 pf0 = __builtin_bit_cast(bf16x8, (u32x4){cvt_pk_bf16(at[0][0], at[0][1]), cvt_pk_bf16(at[0][2], at[0][3]), cvt_pk_bf16(at[1][0], at[1][1]), cvt_pk_bf16(at[1][2], at[1][3])});
                        const bf16x8 pf1 = __builtin_bit_cast(bf16x8, (u32x4){cvt_pk_bf16(at[2][0], at[2][1]), cvt_pk_bf16(at[2][2], at[2][3]), cvt_pk_bf16(at[3][0], at[3][1]), cvt_pk_bf16(at[3][2], at[3][3])});
                        f32x4 o[4];
#pragma unroll
                        for (int c = 0; c < 4; ++c) o[c] = (f32x4){0.f, 0.f, 0.f, 0.f};
                        na_pv(vimg, 0, 16, lane, pf0, o);
                        na_pv(vimg, 32, 48, lane, pf1, o);
                        {   const int q4 = (lane & 15) >> 2, p4 = lane & 3;
                            LAS unsigned char* sfi = lds + 98304 + h * 4096; LAS unsigned char* sbi = sfi + 16384;
#pragma unroll
                            for (int dvt = 0; dvt < 4; ++dvt) {
                                const int o0 = na_off(8 * g + q4, 2 * dvt + (p4 >> 1)) + 8 * (p4 & 1), o1 = na_off(8 * g + 4 + q4, 2 * dvt + (p4 >> 1)) + 8 * (p4 & 1);
                                const s16x4 f0 = na_tr(sfi + o0), f1 = na_tr(sfi + o1), b0 = na_tr(sbi + o0), b1 = na_tr(sbi + o1);
                                const bf16x8 sf = (bf16x8){f0[0], f0[1], f0[2], f0[3], f1[0], f1[1], f1[2], f1[3]}, sb = (bf16x8){b0[0], b0[1], b0[2], b0[3], b1[0], b1[1], b1[2], b1[3]};
                                o[dvt] = __builtin_amdgcn_mfma_f32_16x16x32_bf16(sf, qff, o[dvt], 0, 0, 0);
                                o[dvt] = __builtin_amdgcn_mfma_f32_16x16x32_bf16(sb, qbf, o[dvt], 0, 0, 0);
                            } }
                        float ss = 0.f;
#pragma unroll
                        for (int dvt = 0; dvt < 4; ++dvt) ss += (o[dvt][0] * o[dvt][0] + o[dvt][1] * o[dvt][1]) + (o[dvt][2] * o[dvt][2] + o[dvt][3] * o[dvt][3]);
                        ss += __shfl_xor(ss, 16); ss += __shfl_xor(ss, 32);
                        const float rn = rsqrtf(ss * (1.0f / 64.0f) + EPS);
                        const size_t row = (size_t)(row0 + trow);
#pragma unroll
                        for (int dvt = 0; dvt < 4; ++dvt) {
                            const int dv = 16 * dvt + 4 * g;
                            const f32x4 gn = gnv[dvt];
                            const u32x2 gsw = gsv[ttl][dvt];
                            u32x2 w; w.x = cvt_pk_bf16(o[dvt][0] * rn * gn[0] * bflo(gsw.x), o[dvt][1] * rn * gn[1] * bfhi(gsw.x));
                            w.y = cvt_pk_bf16(o[dvt][2] * rn * gn[2] * bflo(gsw.y), o[dvt][3] * rn * gn[3] * bfhi(gsw.y));
                            *(u32x2*)(Y + row * DM + 768 + h * 64 + dv) = w;
                        }
                    }
                    __syncthreads();
                }
            }
#endif
        }
        SEAM(P + 3);
        for (int rep_ = 1 + ((REPEAT_MASK >> 6) & 1); rep_ > 0 && IN_PH(P + 4); --rep_) { WSL
            pg8::Gemm g{Y, Wout_t + (size_t)l * DM * DM, M, DM, DM}; pg8::StaticOrder S; S.init(M, DM, G, bid, 1);
            EpiRes E{wsl, INP(I_XP), INP(I_XS), (l == 0) ? (const bf16*)nullptr : (const bf16*)outl, outl, XR, l * NCOND * 6144 + 2 * 1024, (l * 2 + 1) * NCOND * DM, rep_ == 2 ? 5 * M : (2 * l + 1) * M, rep_ == 2};
            pg8::gemm_phase<EpiRes, pg8::StaticOrder>(lds, g, S, E, tid);
            { pg8::Unit su; if (S.sub4(0, su)) { int t2_ = tid; asm volatile("" : "+v"(t2_)); pg8::gemm_sub4<EpiRes>(lds, g, su, E, t2_); } }
        }
        SEAM(P + 4);
        for (int rep_ = 1 + ((REPEAT_MASK >> 7) & 1); rep_ > 0 && IN_PH(P + 5); --rep_) { WSL
            pg8::Gemm g{XA, Wffi_t + (size_t)l * FF2 * DM, M, FF2, DM}; pg8::StaticOrder S; S.init(M, FF2, G, bid, 0);
            EpiD E{wsl, l};
            pg8::gemm_phase<EpiD, pg8::StaticOrder>(lds, g, S, E, tid);
            _Pragma("unroll 1") for (int k2_ = 0; k2_ < 2; ++k2_) { pg8::Unit su; if (!S.sub4(k2_, su)) break; int t2_ = tid; asm volatile("" : "+v"(t2_)); pg8::gemm_sub4<EpiD>(lds, g, su, E, t2_); }
        }
        SEAM(P + 5);
        for (int rep_ = 1 + ((REPEAT_MASK >> 8) & 1); rep_ > 0 && IN_PH(P + 6); --rep_) { WSL
            pg8::Gemm g{H, Wffo_t + (size_t)l * DM * DFF, M, DM, DFF}; pg8::StaticOrder S; S.init(M, DM, G, bid, 1);
            const bool more = (l + 1 < DEPTH);
            EpiRes E{wsl, nullptr, nullptr, XR, outl, more ? (bf16*)outl : (bf16*)nullptr, l * NCOND * 6144 + 5 * 1024, more ? ((l + 1) * 2 + 0) * NCOND * DM : -1, rep_ == 2 ? 5 * M : (2 * (l + 1)) * M, rep_ == 2};
            pg8::gemm_phase<EpiRes, pg8::StaticOrder>(lds, g, S, E, tid);
            { pg8::Unit su; if (S.sub4(0, su)) { int t2_ = tid; asm volatile("" : "+v"(t2_)); pg8::gemm_sub4<EpiRes>(lds, g, su, E, t2_); } }
        }
        SEAM(P + 6);
    }
#undef IN_PH
#undef SEAM
#undef GLA_PREP
}

extern "C" void kernel_launch(void* const* d_in, const int* in_sizes, int n_in, void* d_out, int out_size, void* d_ws, size_t ws_size, hipStream_t stream) {
    static int grid = 0;
    if (grid == 0) {
        if (n_in != 26 || ws_size < WS_END) { fprintf(stderr, "kernel_launch: unexpected n_in %d / ws %zu\n", n_in, ws_size); grid = -1; return; }
        int dev = 0, cus = 0, per_cu = 0;
        if (hipGetDevice(&dev) != hipSuccess || hipDeviceGetAttribute(&cus, hipDeviceAttributeMultiprocessorCount, dev) != hipSuccess) { grid = -1; return; }
        if (hipFuncSetAttribute((const void*)fwd_kernel, hipFuncAttributeMaxDynamicSharedMemorySize, LDS_BYTES) != hipSuccess) { fprintf(stderr, "kernel_launch: hipFuncSetAttribute failed\n"); grid = -1; return; }
        if (hipOccupancyMaxActiveBlocksPerMultiprocessor(&per_cu, (const void*)fwd_kernel, 512, LDS_BYTES) != hipSuccess || per_cu < 1) { fprintf(stderr, "kernel_launch: occupancy query says %d\n", per_cu); (void)hipGetLastError(); grid = -1; return; }
        grid = cus;
    }
    if (grid < 0) return;
    (void)hipMemsetAsync((char*)d_ws, 0, ZERO_BYTES, stream);
    Args a{};
    for (int i = 0; i < 26; ++i) a.in[i] = (const float*)d_in[i];
    a.out = (float*)d_out; a.ws = (unsigned char*)d_ws;
#if MK_ONE_LAUNCH
    a.ph_lo = 0; a.ph_hi = NPHASE;
    void* kargs[] = {&a};
    hipError_t e = hipLaunchCooperativeKernel((const void*)fwd_kernel, dim3(grid), dim3(512), kargs, LDS_BYTES, stream);
    if (e != hipSuccess) fprintf(stderr, "kernel_launch: cooperative launch failed: %s\n", hipGetErrorString(e));
#else
    for (int p = 0; p < NPHASE; ++p) { a.ph_lo = p; a.ph_hi = p + 1; hipLaunchKernelGGL(fwd_kernel, dim3(grid), dim3(512), LDS_BYTES, stream, a); }
#endif
}
```

```cpp
#include <hip/hip_runtime.h>
#include <cstdio>
#include <cstdint>
#include <type_traits>

#ifndef REPEAT_MASK
#define REPEAT_MASK 0
#endif
#ifndef REPEAT_EPI
#define REPEAT_EPI 0
#endif
#ifndef MK_ONE_LAUNCH
#define MK_ONE_LAUNCH 1
#endif

#define LAS __attribute__((address_space(3)))
#define GAS __attribute__((address_space(1)))
#define CAS __attribute__((address_space(4)))
typedef unsigned short bf16;
typedef short bf16x8 __attribute__((ext_vector_type(8)));
typedef float f32x4 __attribute__((ext_vector_type(4)));
typedef float f32x2 __attribute__((ext_vector_type(2)));
typedef unsigned u32x4 __attribute__((ext_vector_type(4)));
typedef unsigned u32x2 __attribute__((ext_vector_type(2)));

constexpr int DM = 1024, DEPTH = 2, NCOND = 9;
constexpr int M_CTX = 4096, M_LAT = 32768, M = 36864;
constexpr int IN_W = 2592, IN_WP = 2816, DFF = 2816, FF2 = 5632;
constexpr int NCHUNK = M / 64;
constexpr float EPS = 1e-6f;
constexpr size_t OUT_YP = 0, OUT_YS = (size_t)M_CTX * DM, OUT_K = (size_t)M * DM, OUT_V = OUT_K + 4194304, OUT_GF = OUT_V + 4194304, OUT_GB = OUT_GF + 262144;
constexpr float LOG2E = 1.4426950408889634f;
constexpr float QSCALE = 0.125f * LOG2E;

constexpr size_t MiB = 1u << 20;
constexpr size_t WS_CTL = 0;
constexpr size_t WS_ROWSS = 1 * MiB;
constexpr size_t WS_CVA = 2 * MiB;
constexpr size_t ZERO_BYTES = 3 * MiB;
constexpr size_t WS_CVD = 3 * MiB;
constexpr size_t WS_MODS = 4 * MiB;
constexpr size_t WS_WSC = 5 * MiB;
constexpr size_t WS_ROPE = 5 * MiB + 512 * 1024;
constexpr size_t WS_WIN = 6 * MiB;
constexpr size_t WS_WOUT = 18 * MiB;
constexpr size_t WS_WFFI = 22 * MiB;
constexpr size_t WS_WFFO = 44 * MiB;
constexpr size_t WS_XA = 56 * MiB;
constexpr size_t WS_Y = 128 * MiB;
constexpr size_t WS_P = 200 * MiB;
constexpr size_t WS_U = WS_P;
constexpr size_t WS_Q = WS_P + 18 * MiB;
constexpr size_t WS_K = WS_P + 54 * MiB;
constexpr size_t WS_V = WS_P + 90 * MiB;
constexpr size_t WS_QLK = WS_P + 126 * MiB;
constexpr size_t WS_VL = WS_P + 144 * MiB;
constexpr size_t WS_GS = WS_P + 162 * MiB;
constexpr size_t WS_LR = WS_P + 180 * MiB;
constexpr size_t WS_H = 128 * MiB;
constexpr size_t WS_XR = 326 * MiB;
constexpr size_t WS_UF = 386 * MiB;
constexpr size_t WS_UB = 404 * MiB;
constexpr size_t WS_DF = 422 * MiB;
constexpr size_t WS_DB = 423 * MiB;
constexpr size_t WS_CK = 424 * MiB;
constexpr size_t WS_CV = 432 * MiB;
constexpr size_t WS_QKT = 440 * MiB;
constexpr size_t WS_SINF = 440 * MiB;
constexpr size_t WS_SINB = 458 * MiB;
constexpr size_t WS_STF = 476 * MiB;
constexpr size_t WS_STB = 485 * MiB;
constexpr size_t WS_WPT = 494 * MiB;
constexpr size_t WS_END = 495 * MiB;
static_assert(WS_LR + (size_t)M * 32 * 4 <= WS_UF && WS_H + (size_t)M * DFF * 2 <= WS_XR && WS_XR + (size_t)M * DM * 2 <= WS_DF && WS_END <= 512 * MiB, "ws map");

constexpr int CW_BAR = 4096;

typedef __bf16 bf16x2n __attribute__((ext_vector_type(2)));
__device__ __forceinline__ unsigned cvt_pk_bf16(float lo, float hi) { const f32x2 v = {lo, hi}; return __builtin_bit_cast(unsigned, __builtin_convertvector(v, bf16x2n)); }
__device__ __forceinline__ float bf2f(bf16 b) { return __uint_as_float((unsigned)b << 16); }
__device__ __forceinline__ float bflo(unsigned w) { return __uint_as_float(w << 16); }
__device__ __forceinline__ float bfhi(unsigned w) { return __uint_as_float(w & 0xffff0000u); }
__device__ __forceinline__ float siluf(float x) { return x * __builtin_amdgcn_rcpf(1.0f + __builtin_amdgcn_exp2f(x * -1.4426950408889634f)); }
template <int CTRL> __device__ __forceinline__ float dpp0(float x) { return __int_as_float(__builtin_amdgcn_update_dpp(0, __float_as_int(x), CTRL, 0xf, 0xf, true)); }
__device__ __forceinline__ float rdlane(float x, int l) { return __int_as_float(__builtin_amdgcn_readlane(__float_as_int(x), l)); }
__device__ __forceinline__ float wave_sum(float v) {
#pragma unroll
    for (int o = 1; o < 64; o <<= 1) v += __shfl_xor(v, o);
    return v;
}
__device__ __forceinline__ u32x4 pack8(const f32x4 a, const f32x4 b) {
    u32x4 w; w.x = cvt_pk_bf16(a[0], a[1]); w.y = cvt_pk_bf16(a[2], a[3]); w.z = cvt_pk_bf16(b[0], b[1]); w.w = cvt_pk_bf16(b[2], b[3]); return w;
}

namespace pg8 {
constexpr int BM = 256, BK = 64, HALF = 128, HTB = HALF * BK * 2, STAGE_BYTES = 8 * HTB, NXCD = 8, WGM = 8;
__host__ __device__ __forceinline__ int lds_byte(int r, int c) { const int st = (r >> 4) * 2 + (c >> 5), rr = r & 15, cc = c & 31, ob = rr * 64 + cc * 2; return st * 1024 + (ob ^ (((ob >> 9) & 1) << 5)); }
__host__ __device__ __forceinline__ void stage_rc(int b, int& R, int& C) { const int st = b / 1024, sb = b % 1024, swz = sb ^ (((sb >> 9) & 1) << 5); R = (st >> 1) * 16 + swz / 64; C = (st & 1) * 32 + (swz % 64) / 2; }
struct Unit { int pm, pn, rsh; };
struct Gemm { const bf16* A; const bf16* Bt; int M, N, K; };
struct StaticOrder {
    int nM, nN, nwg, G, c, lim;
    __host__ __device__ __forceinline__ void init(int M_, int N_, int G_, int c_, int S_ = 0) { nM = M_ / BM; nN = N_ / BM; nwg = nM * nN; G = G_; c = c_; lim = nwg;
        const int Lf = nwg % G; if (S_ > 0 && Lf > 0 && (G % NXCD) == 0 && (Lf % NXCD) == 0 && Lf * 4 <= S_ * G) lim = nwg - Lf; }
    __host__ __device__ __forceinline__ void unit_of(int L, Unit& u) const {
        int wgid = L; { const int q = nwg / NXCD, r = nwg % NXCD, xcd = wgid % NXCD, off = wgid / NXCD; wgid = (xcd < r ? xcd * (q + 1) : r * (q + 1) + (xcd - r) * q) + off; }
        const int nig = WGM * nN, gid = wgid / nig, fm = gid * WGM, gsz = (nM - fm) < WGM ? (nM - fm) : WGM;
        u.pm = fm + ((wgid % nig) % gsz); u.pn = (wgid % nig) / gsz; u.rsh = 0;
    }
    __host__ __device__ __forceinline__ bool next(int i, Unit& u) const {
        const long L = (long)i * G + c; if (L >= lim) return false;
        unit_of((int)L, u); return true;
    }
    __host__ __device__ __forceinline__ bool sub4(int k, Unit& u) const {
        if (lim == nwg) return false;
        const int x = c % NXCD, j = c / NXCD + k * (G / NXCD), Lf = nwg - lim; if (j >= 4 * (Lf / NXCD)) return false;
        unit_of(lim + (j >> 2) * NXCD + x, u); const int q = j & 3; u.rsh = 128 * (q >> 1) + 32 * (q & 1); return true;
    }
};
template <class Epi, class Sched>
__device__ __forceinline__ void gemm_phase(LAS unsigned char* lds, const Gemm g, const Sched& S, const Epi& E, const int tid) {
    const int wid = __builtin_amdgcn_readfirstlane(tid >> 6), lane = tid & 63, wr = wid >> 2, wc = wid & 3, fr = lane & 15, fq = lane >> 4;
    const int K = g.K, nt = K / BK;
    unsigned voffA[2];
#pragma unroll
    for (int i = 0; i < 2; ++i) { int R, C; stage_rc(tid * 16 + i * 8192, R, C); voffA[i] = (unsigned)(R * K + C) * 2u; }
    const size_t kstep = (size_t)(BK * 2);
    const size_t hstep = (size_t)HALF * K * 2;
    const size_t tstep = 2 * hstep;
    const unsigned ldsw = (unsigned)wid * 1024u;
    const int aoff = lds_byte(wr * 64 + fr, fq * 8), boff = lds_byte(wc * 32 + fr, fq * 8);
#define PG8_SA(b, h) (((b) * 2 + (h)) * HTB)
#define PG8_SB(b, h) ((4 + (b) * 2 + (h)) * HTB)
#define PG8_STAGE(bufoff, gbase) do { _Pragma("unroll") for (int _i = 0; _i < 2; ++_i) \
        __builtin_amdgcn_global_load_lds((const unsigned*)((const char*)(gbase) + voffA[_i]), (LAS unsigned*)(lds + (bufoff) + ldsw + _i * 8192), 16, 0, 0); } while (0)
#define PG8_LDA(dst, b, h) do { _Pragma("unroll") for (int m = 0; m < 4; ++m) _Pragma("unroll") for (int k = 0; k < 2; ++k) dst[m][k] = *(const LAS bf16x8*)(lds + PG8_SA(b, h) + aoff + m * 2048 + k * 1024); } while (0)
#define PG8_LDB(dst, b, h) do { _Pragma("unroll") for (int n = 0; n < 2; ++n) _Pragma("unroll") for (int k = 0; k < 2; ++k) dst[n][k] = *(const LAS bf16x8*)(lds + PG8_SB(b, h) + boff + n * 2048 + k * 1024); } while (0)
#define PG8_MMA(ai, bj, At, Bt) do { __builtin_amdgcn_s_setprio(1); _Pragma("unroll") for (int m = 0; m < 4; ++m) _Pragma("unroll") for (int n = 0; n < 2; ++n) _Pragma("unroll") for (int k = 0; k < 2; ++k) \
        acc[ai][bj][m][n] = __builtin_amdgcn_mfma_f32_16x16x32_bf16(Bt[n][k], At[m][k], acc[ai][bj][m][n], 0, 0, 0); __builtin_amdgcn_s_setprio(0); } while (0)
#define PG8_WAIT_V(n) asm volatile("s_waitcnt vmcnt(" #n ")" ::: "memory")
#define PG8_WAIT_L(n) asm volatile("s_waitcnt lgkmcnt(" #n ")" ::: "memory")
#define PG8_BAR __builtin_amdgcn_s_barrier()
#define PG8_SCHED __builtin_amdgcn_sched_barrier(0)
    Unit cur, nxt; int ui = 0;
    if (!S.next(0, cur)) return;
    constexpr int PF_OFF = 131072 + 4096;
    if constexpr (Epi::PREF) E.pref(lds + PF_OFF, cur, wid, lane);
    f32x4 acc[2][2][4][2];
#pragma unroll
    for (int a = 0; a < 2; ++a)
#pragma unroll
        for (int b = 0; b < 2; ++b)
#pragma unroll
            for (int m = 0; m < 4; ++m)
#pragma unroll
                for (int n = 0; n < 2; ++n) acc[a][b][m][n] = (f32x4){0.f, 0.f, 0.f, 0.f};
    bf16x8 At[4][2], B0[2][2], B1[2][2];
    const char* cA = (const char*)g.A + (size_t)cur.pm * tstep; const char* cB = (const char*)g.Bt + (size_t)cur.pn * tstep;
    PG8_STAGE(PG8_SB(0, 0), cB); PG8_STAGE(PG8_SB(0, 1), cB + hstep); PG8_STAGE(PG8_SA(0, 0), cA); PG8_STAGE(PG8_SA(0, 1), cA + hstep);
    if (wr == 1) PG8_BAR;
    PG8_WAIT_V(2); PG8_BAR;
    PG8_STAGE(PG8_SB(1, 0), cB + kstep); PG8_STAGE(PG8_SA(1, 0), cA + kstep); PG8_STAGE(PG8_SB(1, 1), cB + hstep + kstep);
    PG8_WAIT_V(6); PG8_BAR;
    for (;;) {
        const bool has_next = S.next(ui + 1, nxt);
        const char* nA = has_next ? (const char*)g.A + (size_t)nxt.pm * tstep : cA; const char* nB = has_next ? (const char*)g.Bt + (size_t)nxt.pn * tstep : cB;
        for (int t = 0; t < nt; t += 2) {
            const bool last = (t == nt - 2);
            const char* a1 = cA + (size_t)(t + 1) * kstep;
            const char* a2 = last ? nA : cA + (size_t)(t + 2) * kstep; const char* b2 = last ? nB : cB + (size_t)(t + 2) * kstep;
            const char* a3 = a2 + kstep; const char* b3 = b2 + kstep;
            PG8_LDB(B0, 0, 0); PG8_LDB(B1, 0, 1); PG8_SCHED; PG8_LDA(At, 0, 0); PG8_STAGE(PG8_SA(1, 1), a1 + hstep);
            PG8_WAIT_V(8); PG8_WAIT_L(0); PG8_BAR; PG8_MMA(0, 0, At, B0); PG8_MMA(0, 1, At, B1); PG8_BAR; PG8_SCHED;
            PG8_LDA(At, 0, 1); PG8_STAGE(PG8_SB(0, 0), b2); PG8_STAGE(PG8_SB(0, 1), b2 + hstep); PG8_STAGE(PG8_SA(0, 0), a2);
            PG8_WAIT_V(8); PG8_WAIT_L(0); PG8_BAR; PG8_MMA(1, 0, At, B0); PG8_MMA(1, 1, At, B1); PG8_BAR; PG8_SCHED;
            PG8_LDB(B0, 1, 0); PG8_LDB(B1, 1, 1); PG8_SCHED; PG8_LDA(At, 1, 0); PG8_STAGE(PG8_SA(0, 1), a2 + hstep);
            PG8_WAIT_V(8); PG8_WAIT_L(0); PG8_BAR; PG8_MMA(0, 0, At, B0); PG8_MMA(0, 1, At, B1); PG8_BAR; PG8_SCHED;
            PG8_LDA(At, 1, 1); PG8_STAGE(PG8_SB(1, 0), b3); PG8_STAGE(PG8_SB(1, 1), b3 + hstep); PG8_STAGE(PG8_SA(1, 0), a3);
            PG8_WAIT_V(8); PG8_WAIT_L(0); PG8_BAR; PG8_MMA(1, 0, At, B0); PG8_MMA(1, 1, At, B1); PG8_BAR; PG8_SCHED;
        }
        if (wr == 0) PG8_BAR;
        if constexpr (Epi::PREF) { if (has_next) E.pref(lds + PF_OFF + ((ui + 1) & 1) * 2048, nxt, wid, lane); }
        E.template run<2, 4, Epi::PREF>(acc, cur, wr, wc, fr, fq, (const LAS float*)(lds + PF_OFF + (ui & 1) * 2048));
        if constexpr (REPEAT_EPI && Epi::IDEMPOTENT) { asm volatile("" ::: "memory"); E.template run<2, 4, Epi::PREF>(acc, cur, wr, wc, fr, fq, (const LAS float*)(lds + PF_OFF + (ui & 1) * 2048)); }
        if (!has_next) break;
#pragma unroll
        for (int a = 0; a < 2; ++a)
#pragma unroll
            for (int b = 0; b < 2; ++b)
#pragma unroll
                for (int m = 0; m < 4; ++m)
#pragma unroll
                    for (int n = 0; n < 2; ++n) acc[a][b][m][n] = (f32x4){0.f, 0.f, 0.f, 0.f};
        cur = nxt; cA = nA; cB = nB; ++ui;
        if (wr == 1) PG8_BAR;
    }
    PG8_WAIT_V(0);
    PG8_BAR;
#undef PG8_SA
#undef PG8_SB
#undef PG8_STAGE
#undef PG8_LDA
#undef PG8_LDB
#undef PG8_MMA
}
constexpr int SUB_STB = 2 * HTB + 8192;
template <class Epi>
__device__ __forceinline__ void gemm_sub4(LAS unsigned char* lds, const Gemm g, const Unit cur, const Epi& E, const int tid) {
    const int wid = __builtin_amdgcn_readfirstlane(tid >> 6), lane = tid & 63, wr = wid >> 2, wc = wid & 3, fr = lane & 15, fq = lane >> 4;
    const int K = g.K, nt = K / BK;
    unsigned voffB[2], voffQ;
#pragma unroll
    for (int i = 0; i < 2; ++i) { int R, C; stage_rc(tid * 16 + i * 8192, R, C); voffB[i] = (unsigned)(R * K + C) * 2u; }
    { int R, C; stage_rc(tid * 16, R, C); voffQ = (unsigned)((64 * (R >> 5) + (R & 31)) * K + C) * 2u; }
    const size_t kstep = (size_t)(BK * 2);
    const size_t hstep = (size_t)HALF * K * 2;
    const size_t tstep = 2 * hstep;
    const unsigned ldsw = (unsigned)wid * 1024u;
    const int aoff = 2 * HTB + lds_byte(wr * 32 + fr, fq * 8), boff = lds_byte(wc * 32 + fr, fq * 8);
    const char* cA = (const char*)g.A + (size_t)cur.pm * tstep + (size_t)cur.rsh * K * 2; const char* cB = (const char*)g.Bt + (size_t)cur.pn * tstep;
#define SUB_STAGE(so, tile) do { const char* b_ = cB + (size_t)(tile) * kstep; const char* a_ = cA + (size_t)(tile) * kstep; \
        _Pragma("unroll") for (int _h = 0; _h < 2; ++_h) _Pragma("unroll") for (int _i = 0; _i < 2; ++_i) \
            __builtin_amdgcn_global_load_lds((const unsigned*)(b_ + _h * hstep + voffB[_i]), (LAS unsigned*)(lds + (so) + _h * HTB + ldsw + _i * 8192), 16, 0, 0); \
        __builtin_amdgcn_global_load_lds((const unsigned*)(a_ + voffQ), (LAS unsigned*)(lds + (so) + 2 * HTB + ldsw), 16, 0, 0); } while (0)
#define SUB_LD(Aq, Bq0, Bq1, so) do { _Pragma("unroll") for (int n = 0; n < 2; ++n) _Pragma("unroll") for (int k = 0; k < 2; ++k) { \
            Bq0[n][k] = *(const LAS bf16x8*)(lds + (so) + boff + n * 2048 + k * 1024); Bq1[n][k] = *(const LAS bf16x8*)(lds + (so) + HTB + boff + n * 2048 + k * 1024); } \
        _Pragma("unroll") for (int m = 0; m < 2; ++m) _Pragma("unroll") for (int k = 0; k < 2; ++k) Aq[m][k] = *(const LAS bf16x8*)(lds + (so) + aoff + m * 2048 + k * 1024); } while (0)
#define SUB_MMA(Aq, Bq0, Bq1) do { __builtin_amdgcn_s_setprio(1); _Pragma("unroll") for (int m = 0; m < 2; ++m) _Pragma("unroll") for (int n = 0; n < 2; ++n) _Pragma("unroll") for (int k = 0; k < 2; ++k) { \
            acc[0][0][m][n] = __builtin_amdgcn_mfma_f32_16x16x32_bf16(Bq0[n][k], Aq[m][k], acc[0][0][m][n], 0, 0, 0); \
            acc[0][1][m][n] = __builtin_amdgcn_mfma_f32_16x16x32_bf16(Bq1[n][k], Aq[m][k], acc[0][1][m][n], 0, 0, 0); } __builtin_amdgcn_s_setprio(0); } while (0)
    f32x4 acc[2][2][4][2];
#pragma unroll
    for (int b = 0; b < 2; ++b)
#pragma unroll
        for (int m = 0; m < 2; ++m)
#pragma unroll
            for (int n = 0; n < 2; ++n) acc[0][b][m][n] = (f32x4){0.f, 0.f, 0.f, 0.f};
    bf16x8 A0[2][2], A1[2][2], B00[2][2], B01[2][2], B10[2][2], B11[2][2];
    SUB_STAGE(0, 0); SUB_STAGE(SUB_STB, 1); SUB_STAGE(2 * SUB_STB, 2);
    PG8_WAIT_V(10); PG8_BAR;
    SUB_LD(A0, B00, B01, 0);
    PG8_WAIT_V(5); PG8_WAIT_L(0); PG8_BAR;
    int so = 0;
    for (int t = 0; t < nt; t += 2) {
        {   const int so1 = (so == 2 * SUB_STB) ? 0 : so + SUB_STB; const bool st3 = t + 3 < nt;
            if (st3) SUB_STAGE(so, t + 3);
            SUB_LD(A1, B10, B11, so1); PG8_SCHED;
            SUB_MMA(A0, B00, B01);
            if (st3) PG8_WAIT_V(5); else PG8_WAIT_V(0);
            PG8_WAIT_L(0); PG8_BAR; so = so1; }
        {   const int so1 = (so == 2 * SUB_STB) ? 0 : so + SUB_STB; const bool st3 = t + 4 < nt, rd = t + 2 < nt;
            if (st3) SUB_STAGE(so, t + 4);
            if (rd) SUB_LD(A0, B00, B01, so1);
            PG8_SCHED;
            SUB_MMA(A1, B10, B11);
            if (st3) PG8_WAIT_V(5); else PG8_WAIT_V(0);
            PG8_WAIT_L(0); PG8_BAR; so = so1; }
    }
    E.template run<1, 2, false>(acc, cur, wr, wc, fr, fq, nullptr);
#undef SUB_STAGE
#undef SUB_LD
#undef SUB_MMA
#undef PG8_WAIT_V
#undef PG8_WAIT_L
#undef PG8_BAR
#undef PG8_SCHED
}
}

__device__ __forceinline__ int lgroup(int kind, int p0) {
    const int pn = p0 >> 8, pg = (p0 >> 5) & 7;
    if (kind == 0) { const int l = 256 * pn + 32 * (((pg & 3) << 1) | (pg >> 2)); return l < IN_W ? l : -1; }
    if (kind == 2) return (pg >> 2) * DFF + 128 * pn + 32 * (pg & 3);
    return p0;
}
__device__ __forceinline__ int llow5(bool rope, int p) {
    return rope ? ((((p >> 3) & 1) << 4) | (((p >> 4) & 1) << 3) | (((p >> 2) & 1) << 2) | (p & 3))
                : ((((p >> 2) & 3) << 3) | (((p >> 4) & 1) << 2) | (p & 3));
}
__device__ __forceinline__ int plow(bool rope, int l) {
    return rope ? ((((l >> 3) & 1) << 4) | (((l >> 4) & 1) << 3) | (((l >> 2) & 1) << 2) | (l & 3))
                : ((((l >> 2) & 1) << 4) | (((l >> 3) & 3) << 2) | (l & 3));
}

typedef const f32x4 (&AccRef)[2][2][4][2];
__device__ __forceinline__ int cond_of_pm(int pm) { return pm < 16 ? 8 : ((pm - 16) >> 4); }
#define EPI_FENCE() asm volatile("" ::: "memory")
template <class T> __device__ __forceinline__ T* wsptr(unsigned char* ws, size_t off) { return (T*)(ws + off); }

struct EpiA {
    static constexpr bool IDEMPOTENT = true, PREF = true;
    int layer; unsigned char* ws; float* out; const float* qg; const float* kg;
    __device__ __forceinline__ void pref(LAS unsigned char* dst, const pg8::Unit& u, int wid, int lane) const {
        if (wid < 2) {
            GAS unsigned char* wg_ = (GAS unsigned char*)ws; asm volatile("" : "+s"(wg_)); unsigned char* w = (unsigned char*)wg_;
            const float* src;
            if (wid == 0) src = wsptr<float>(w, WS_ROWSS) + (size_t)(2 * layer) * M + u.pm * 256 + lane * 4;
            else src = wsptr<float>(w, WS_CVA) + ((size_t)layer * NCOND + cond_of_pm(u.pm)) * IN_WP + u.pn * 256 + lane * 4;
            __builtin_amdgcn_global_load_lds((const unsigned*)src, (LAS unsigned*)(dst + wid * 1024), 16, 0, 0);
        }
    }
    template <int NAI, int NM, bool PF> __device__ __forceinline__ void run(AccRef acc, const pg8::Unit& u, int wr, int wc, int fr_, int fq_, const LAS float* Pf) const {
        GAS unsigned char* wg_ = (GAS unsigned char*)ws; int fr = fr_, fq = fq_; asm volatile("" : "+s"(wg_), "+v"(fr), "+v"(fq)); unsigned char* w = (unsigned char*)wg_;
        const int pn = u.pn, pm = u.pm, ci = cond_of_pm(pm);
        const float* rowss = wsptr<float>(w, WS_ROWSS) + (size_t)(2 * layer) * M;
        const bool isrope = (pn == 7);
        int off[2];
#pragma unroll
        for (int n = 0; n < 2; ++n) off[n] = isrope ? (16 * (fq >> 1) + 8 * n + 4 * (fq & 1)) : (8 * fq + 4 * n);
        const float* cv = wsptr<float>(w, WS_CVA) + ((size_t)layer * NCOND + ci) * IN_WP + pn * 256 + wc * 64;
#define EPIA_CVV f32x4 cvv[2][2]; _Pragma("unroll") for (int bj = 0; bj < 2; ++bj) _Pragma("unroll") for (int n = 0; n < 2; ++n) { \
            if constexpr (PF) cvv[bj][n] = *(const LAS f32x4*)(Pf + 256 + wc * 64 + 32 * bj + off[n]); else cvv[bj][n] = *(const f32x4*)(cv + 32 * bj + off[n]); }
        const int rbase = pm * 256 + u.rsh + wr * 64 + fr;
#define EPIA_RS(ai) float rsv[NM]; _Pragma("unroll") for (int j = 0; j < NM; ++j) { if constexpr (PF) rsv[j] = Pf[wr * 64 + fr + (ai) * 128 + j * 16]; else rsv[j] = rowss[rbase + (ai) * 128 + j * 16]; } \
        _Pragma("unroll") for (int j = 0; j < NM; ++j) rsv[j] = rsqrtf(rsv[j] * (1.0f / DM) + EPS);
#define EPIA_X(ai, m) const int r = rbase + (ai) * 128 + (m) * 16; const float rs = rsv[(m)]; f32x4 x[2][2]; \
        _Pragma("unroll") for (int bj = 0; bj < 2; ++bj) _Pragma("unroll") for (int n = 0; n < 2; ++n) x[bj][n] = acc[ai][bj][m][n] * rs + cvv[bj][n];
#define EPIA_LOOP _Pragma("unroll") for (int ai = 0; ai < NAI; ++ai) { EPIA_RS(ai) _Pragma("unroll") for (int m = 0; m < NM; ++m)
        if (pn == 0 || pn == 8) {
            bf16* dst = wsptr<bf16>(w, pn == 0 ? WS_U : WS_VL); EPIA_CVV
            EPIA_LOOP { EPIA_X(ai, m)
#pragma unroll
                for (int bj = 0; bj < 2; ++bj) *(u32x4*)(dst + (size_t)r * 256 + wc * 64 + 32 * bj + 8 * fq) = pack8(x[bj][0], x[bj][1]);
                EPI_FENCE(); } }
        } else if (pn <= 6) {
            const int which = (pn - 1) >> 1, hh = ((pn - 1) & 1) * 4 + wc; EPIA_CVV
            const float* gp = ((which == 0) ? qg : kg) + 8 * fq;
            bf16* dst = wsptr<bf16>(w, which == 0 ? WS_Q : (which == 1 ? WS_K : WS_V));
            float* ob = out + (which == 1 ? OUT_K : OUT_V) + ((size_t)((pm * 2 + layer) * 8 + hh) * 256) * 64;
            EPIA_LOOP { EPIA_X(ai, m)
                if (which < 2) {
                    float ss = 0.f;
#pragma unroll
                    for (int bj = 0; bj < 2; ++bj)
#pragma unroll
                        for (int n = 0; n < 2; ++n) { const f32x4 v = x[bj][n]; ss += (v[0] * v[0] + v[1] * v[1]) + (v[2] * v[2] + v[3] * v[3]); }
                    ss += __shfl_xor(ss, 16); ss += __shfl_xor(ss, 32);
                    float rn = rsqrtf(ss * (1.0f / 64.0f) + EPS); if (which == 0) rn *= QSCALE;
#pragma unroll
                    for (int bj = 0; bj < 2; ++bj)
#pragma unroll
                        for (int n = 0; n < 2; ++n) x[bj][n] = x[bj][n] * rn * *(const f32x4*)(gp + 32 * bj + 4 * n);
                }
#pragma unroll
                for (int bj = 0; bj < 2; ++bj) *(u32x4*)(dst + (size_t)r * 512 + hh * 64 + 32 * bj + 8 * fq) = pack8(x[bj][0], x[bj][1]);
                if (which >= 1 && pm < 16) {
                    float* o = ob + (size_t)(r - pm * 256) * 64;
#pragma unroll
                    for (int bj = 0; bj < 2; ++bj)
#pragma unroll
                        for (int n = 0; n < 2; ++n) *(f32x4*)(o + 32 * bj + 8 * fq + 4 * n) = x[bj][n];
                }
                EPI_FENCE(); } }
        } else if (pn == 7) {
            const bool isq = wc < 2;
            bf16* QLK = wsptr<bf16>(w, WS_QLK); const float* rope = wsptr<float>(w, WS_ROPE); EPIA_CVV
            EPIA_LOOP { EPIA_X(ai, m)
                const int t = (r - M_CTX) & 4095;
                const int pos = (fq >> 1) ? (t & 63) : (t >> 6);
                f32x4 cs = (f32x4){1.f, 1.f, 1.f, 1.f}, sn = (f32x4){0.f, 0.f, 0.f, 0.f};
                if (pm >= 16) {
                    const f32x4* rp = (const f32x4*)(rope + (size_t)pos * 16 + 8 * (fq & 1));
                    const f32x4 c01 = rp[0], c23 = rp[1];
                    cs = (f32x4){c01[0], c01[2], c23[0], c23[2]}; sn = (f32x4){c01[1], c01[3], c23[1], c23[3]};
                }
#pragma unroll
                for (int bj = 0; bj < 2; ++bj) {
                    f32x4 x1 = x[bj][0], x2 = x[bj][1];
                    if (isq) { x1 = x1 * 0.17677669529663687f; x2 = x2 * 0.17677669529663687f; }
                    const f32x4 o1 = x1 * cs - x2 * sn, o2 = x2 * cs + x1 * sn;
                    bf16* d = QLK + (size_t)r * 256 + wc * 64 + 32 * bj;
                    u32x2 w1, w2; w1.x = cvt_pk_bf16(o1[0], o1[1]); w1.y = cvt_pk_bf16(o1[2], o1[3]); w2.x = cvt_pk_bf16(o2[0], o2[1]); w2.y = cvt_pk_bf16(o2[2], o2[3]);
                    *(u32x2*)(d + off[0]) = w1; *(u32x2*)(d + off[1]) = w2;
                }
                EPI_FENCE(); } }
        } else if (pn == 9) {
            bf16* GS = wsptr<bf16>(w, WS_GS); EPIA_CVV
            EPIA_LOOP { EPIA_X(ai, m)
#pragma unroll
                for (int bj = 0; bj < 2; ++bj) { f32x4 a = x[bj][0], b = x[bj][1];
#pragma unroll
                    for (int i = 0; i < 4; ++i) { a[i] = siluf(a[i]); b[i] = siluf(b[i]); }
                    *(u32x4*)(GS + (size_t)r * 256 + wc * 64 + 32 * bj + 8 * fq) = pack8(a, b); }
                EPI_FENCE(); } }
        } else {
            float* LR = wsptr<float>(w, WS_LR);
            if (wc == 0) { EPIA_CVV
                EPIA_LOOP { EPIA_X(ai, m)
#pragma unroll
                    for (int n = 0; n < 2; ++n) *(f32x4*)(LR + (size_t)r * 32 + 8 * fq + 4 * n) = x[0][n];
                    EPI_FENCE(); } }
            }
        }
#undef EPIA_CVV
#undef EPIA_X
#undef EPIA_RS
#undef EPIA_LOOP
    }
};

struct EpiRes {
    static constexpr bool IDEMPOTENT = false, PREF = true;
    unsigned char* ws; const float* base_ctx; const float* base_lat;   const bf16* base_h;
    float* out;   bf16* dst_h;   int gate_off;
    int wsc_off;   int rowss_off; int dry;
    __device__ __forceinline__ void pref(LAS unsigned char* dst, const pg8::Unit& u, int wid, int lane) const {
        if (wid < 2) {
            GAS unsigned char* wg_ = (GAS unsigned char*)ws; asm volatile("" : "+s"(wg_)); unsigned char* w = (unsigned char*)wg_;
            const int ci = cond_of_pm(u.pm);
            const float* src;
            if (wid == 0) src = wsptr<float>(w, WS_MODS) + gate_off + (size_t)ci * 6144 + u.pn * 256 + lane * 4;
            else src = wsptr<float>(w, WS_WSC) + (wsc_off >= 0 ? wsc_off : 0) + (size_t)ci * DM + u.pn * 256 + lane * 4;
            __builtin_amdgcn_global_load_lds((const unsigned*)src, (LAS unsigned*)(dst + wid * 1024), 16, 0, 0);
        }
    }
    template <int NAI, int NM, bool PF> __device__ __forceinline__ void run(AccRef acc, const pg8::Unit& u, int wr, int wc, int fr_, int fq_, const LAS float* Pf) const {
        GAS unsigned char* wg_ = (GAS unsigned char*)ws; int fr = fr_, fq = fq_; asm volatile("" : "+s"(wg_), "+v"(fr), "+v"(fq)); unsigned char* w = (unsigned char*)wg_;
        const int pn = u.pn, pm = u.pm, ci = cond_of_pm(pm);
        const int colb = pn * 256 + wc * 32 + 8 * fq;
        const bool more = wsc_off >= 0;
        const float* gate = wsptr<float>(w, WS_MODS) + gate_off + (size_t)ci * 6144 + colb;
        const float* wsc = wsptr<float>(w, WS_WSC) + (more ? wsc_off : 0) + (size_t)ci * DM + colb;
        float* rowss = wsptr<float>(w, WS_ROWSS) + rowss_off;
        bf16* XA = wsptr<bf16>(w, WS_XA);
        const int rl0 = u.rsh + wr * 64 + fr;
        f32x4 gt[2][2], wsv[2][2];
#pragma unroll
        for (int bj = 0; bj < 2; ++bj)
#pragma unroll
            for (int n = 0; n < 2; ++n) {
                if constexpr (PF) { gt[bj][n] = *(const LAS f32x4*)(Pf + wc * 32 + 8 * fq + 128 * bj + 4 * n); wsv[bj][n] = *(const LAS f32x4*)(Pf + 256 + wc * 32 + 8 * fq + 128 * bj + 4 * n); }
                else { gt[bj][n] = *(const f32x4*)(gate + 128 * bj + 4 * n); wsv[bj][n] = *(const f32x4*)(wsc + 128 * bj + 4 * n); } }
        auto body = [&](auto bb_, auto db_) __attribute__((always_inline)) {
            constexpr bool BB = decltype(bb_)::value, DB = decltype(db_)::value;
            const float* bp0 = (pm < 16) ? (base_ctx + (size_t)(pm * 256) * DM) : (base_lat + (size_t)(pm * 256 - M_CTX) * DM);
            const bf16* bh0 = base_h + (size_t)(pm * 256) * DM;
#pragma unroll
            for (int am = 0; am < NAI * NM / 2; ++am) {
                const int ai = am >> 1, m0 = (am & 1) * 2;
                f32x4 pre[2][2][2]; u32x4 preh[2][2];
#pragma unroll
                for (int mm = 0; mm < 2; ++mm)
#pragma unroll
                    for (int bj = 0; bj < 2; ++bj) {
                        const size_t ro = (size_t)(rl0 + ai * 128 + (m0 + mm) * 16) * DM + colb + 128 * bj;
                        if constexpr (BB) preh[mm][bj] = *(const u32x4*)(bh0 + ro);
                        else { pre[mm][bj][0] = *(const f32x4*)(bp0 + ro); pre[mm][bj][1] = *(const f32x4*)(bp0 + ro + 4); }
                    }
#pragma unroll
                for (int mm = 0; mm < 2; ++mm) {
                    const int m = m0 + mm, rl = rl0 + ai * 128 + m * 16;
                    float ss = 0.f;
#pragma unroll
                    for (int bj = 0; bj < 2; ++bj) {
                        const size_t oo = (size_t)(pm * 256 + rl) * DM + colb + 128 * bj;
                        f32x4 b0, b1;
                        if constexpr (BB) { const u32x4 hw = preh[mm][bj]; b0 = (f32x4){bflo(hw.x), bfhi(hw.x), bflo(hw.y), bfhi(hw.y)}; b1 = (f32x4){bflo(hw.z), bfhi(hw.z), bflo(hw.w), bfhi(hw.w)}; }
                        else { b0 = pre[mm][bj][0]; b1 = pre[mm][bj][1]; }
                        const f32x4 v0 = b0 + gt[bj][0] * acc[ai][bj][m][0], v1 = b1 + gt[bj][1] * acc[ai][bj][m][1];
                        if (!dry) { if constexpr (DB) *(u32x4*)(dst_h + oo) = pack8(v0, v1); else { *(f32x4*)(out + oo) = v0; *(f32x4*)(out + oo + 4) = v1; } }
                        ss += ((v0[0] * v0[0] + v0[1] * v0[1]) + (v0[2] * v0[2] + v0[3] * v0[3])) + ((v1[0] * v1[0] + v1[1] * v1[1]) + (v1[2] * v1[2] + v1[3] * v1[3]));
                        if (more && !dry) *(u32x4*)(XA + oo) = pack8(v0 * wsv[bj][0], v1 * wsv[bj][1]);
                    }
                    if (more) { ss += __shfl_xor(ss, 16); ss += __shfl_xor(ss, 32); if (fq == 0) atomicAdd(rowss + pm * 256 + rl, ss); }
                }
                EPI_FENCE();
            }
        };
        if (base_h) { if (dst_h) body(std::true_type{}, std::true_type{}); else body(std::true_type{}, std::false_type{}); }
        else body(std::false_type{}, std::true_type{});
    }
};

struct EpiD {
    static constexpr bool IDEMPOTENT = true, PREF = true;
    unsigned char* ws; int layer;
    __device__ __forceinline__ void pref(LAS unsigned char* dst, const pg8::Unit& u, int wid, int lane) const {
        if (wid < 2) {
            GAS unsigned char* wg_ = (GAS unsigned char*)ws; asm volatile("" : "+s"(wg_)); unsigned char* w = (unsigned char*)wg_;
            const float* src;
            if (wid == 0) src = wsptr<float>(w, WS_ROWSS) + (size_t)(2 * layer + 1) * M + u.pm * 256 + lane * 4;
            else src = wsptr<float>(w, WS_CVD) + ((size_t)layer * NCOND + cond_of_pm(u.pm)) * FF2 + u.pn * 128 + ((lane < 32) ? lane * 4 : DFF + (lane - 32) * 4);
            __builtin_amdgcn_global_load_lds((const unsigned*)src, (LAS unsigned*)(dst + wid * 1024), 16, 0, 0);
        }
    }
    template <int NAI, int NM, bool PF> __device__ __forceinline__ void run(AccRef acc, const pg8::Unit& u, int wr, int wc, int fr_, int fq_, const LAS float* Pf) const {
        GAS unsigned char* wg_ = (GAS unsigned char*)ws; int fr = fr_, fq = fq_; asm volatile("" : "+s"(wg_), "+v"(fr), "+v"(fq)); unsigned char* w = (unsigned char*)wg_;
        const int pn = u.pn, pm = u.pm, ci = cond_of_pm(pm);
        const int jb = pn * 128 + wc * 32 + 8 * fq;
        const float* rowss = wsptr<float>(w, WS_ROWSS) + (size_t)(2 * layer + 1) * M;
        const float* cvec = wsptr<float>(w, WS_CVD) + ((size_t)layer * NCOND + ci) * FF2 + jb;
        bf16* H = wsptr<bf16>(w, WS_H);
        f32x4 cg[2], cu[2];
        float rsv[2][4];
        if constexpr (PF) {
#pragma unroll
            for (int n = 0; n < 2; ++n) { cg[n] = *(const LAS f32x4*)(Pf + 256 + wc * 32 + 8 * fq + 4 * n); cu[n] = *(const LAS f32x4*)(Pf + 384 + wc * 32 + 8 * fq + 4 * n); }
#pragma unroll
            for (int ai = 0; ai < NAI; ++ai)
#pragma unroll
                for (int m = 0; m < NM; ++m) rsv[ai][m] = Pf[ai * 128 + wr * 64 + m * 16 + fr];
        } else {
#pragma unroll
            for (int n = 0; n < 2; ++n) { cg[n] = *(const f32x4*)(cvec + 4 * n); cu[n] = *(const f32x4*)(cvec + DFF + 4 * n); }
#pragma unroll
            for (int ai = 0; ai < NAI; ++ai)
#pragma unroll
                for (int m = 0; m < NM; ++m) rsv[ai][m] = rowss[pm * 256 + u.rsh + ai * 128 + wr * 64 + m * 16 + fr];
        }
#pragma unroll
        for (int ai = 0; ai < NAI; ++ai)
#pragma unroll
            for (int m = 0; m < NM; ++m) rsv[ai][m] = rsqrtf(rsv[ai][m] * (1.0f / DM) + EPS);
#pragma unroll
        for (int n = 0; n < 2; ++n) { cg[n] = cg[n] * -1.4426950408889634f; cu[n] = cu[n] * -0.6931471805599453f; }
#pragma unroll
        for (int ai = 0; ai < NAI; ++ai)
#pragma unroll
            for (int m = 0; m < NM; ++m) {
                const int r = pm * 256 + u.rsh + ai * 128 + wr * 64 + m * 16 + fr;
                const float rs2 = rsv[ai][m] * -1.4426950408889634f, rs3 = rsv[ai][m] * -0.6931471805599453f;
                f32x4 h[2];
#pragma unroll
                for (int n = 0; n < 2; ++n) { const f32x4 g2 = acc[ai][0][m][n] * rs2 + cg[n], u3 = acc[ai][1][m][n] * rs3 + cu[n];
#pragma unroll
                    for (int i = 0; i < 4; ++i) h[n][i] = (g2[i] * u3[i]) * __builtin_amdgcn_rcpf(1.0f + __builtin_amdgcn_exp2f(g2[i])); }
                *(u32x4*)(H + (size_t)r * DFF + jb) = pack8(h[0], h[1]);
                if (m & 1) EPI_FENCE();
            }
    }
};

#define XB_TMO      128
#define XB_XCNT(j)  (256  + 64 * (j))
#define XB_XSUB(j)  (1280 + 64 * (j))
#define XB_XGEN(j)  (2304 + 64 * (j))
#define XB_TOP      3328
#define XB_TOPGEN   3392
#define XCD_BAR_WORDS 3456
#define XB_SPIN_CAP (1u << 18)
__device__ __forceinline__ unsigned xb_ld(unsigned* p)              { return __hip_atomic_load(p, __ATOMIC_RELAXED, __HIP_MEMORY_SCOPE_AGENT); }
__device__ __forceinline__ unsigned xb_add(unsigned* p, unsigned v) { return __hip_atomic_fetch_add(p, v, __ATOMIC_RELAXED, __HIP_MEMORY_SCOPE_AGENT); }
__device__ __forceinline__ unsigned xb_xcc_id() { return (unsigned)__builtin_amdgcn_s_getreg((3 << 11) | 20) & 0xFu; }
#define XB_SPIN(cond, bar) do { unsigned _sp = 0; while (cond) { __builtin_amdgcn_s_sleep(1); \
    if ((++_sp & 255u) == 0u) { if (xb_ld(&(bar)[XB_TMO])) break; if (_sp > XB_SPIN_CAP) { atomicAdd(&(bar)[XB_TMO], 1u); break; } } } } while (0)
struct XcdBarrier { unsigned* bar; unsigned x; volatile LAS unsigned* st; };
__device__ __forceinline__ XcdBarrier xcd_barrier_post(unsigned* bar, volatile LAS unsigned* st) {
    XcdBarrier b; b.bar = bar; b.x = xb_xcc_id(); b.st = st;
    if (threadIdx.x == 0) (void)xb_add(&bar[XB_XCNT(b.x)], 1u);
    return b;
}
__device__ __forceinline__ void xcd_barrier_complete(unsigned* bar, unsigned x, unsigned& nloc, unsigned& nx) {
    const unsigned G = gridDim.x * gridDim.y * gridDim.z;
    unsigned sum, cnt, mine, sp = 0u;
    for (;;) {
        sum = 0u; cnt = 0u; mine = 0u;
#pragma unroll
        for (unsigned j = 0; j < 16; ++j) { const unsigned c = xb_ld(&bar[XB_XCNT(j)]); sum += c; cnt += (c > 0u) ? 1u : 0u; mine = (j == x) ? c : mine; }
        if (sum == G) break;
        __builtin_amdgcn_s_sleep(1);
        if ((++sp & 255u) == 0u) { if (xb_ld(&bar[XB_TMO])) break; if (sp > XB_SPIN_CAP) { atomicAdd(&bar[XB_TMO], 1u); break; } }
    }
    nloc = mine > 0u ? mine : 1u; nx = cnt > 0u ? cnt : 1u;
}
#define XB_SXSUB(j) (3520 + 64 * (j))
#define XB_STOP     4544
#define XB_SGEN     4608
__device__ __forceinline__ void xcd_split_arrive(const XcdBarrier& b) {
    asm volatile("s_waitcnt vmcnt(0)" ::: "memory");
    __syncthreads();
    if (threadIdx.x == 0) {
        unsigned* bar = b.bar;
        __builtin_amdgcn_s_waitcnt(0);
        unsigned nloc = b.st[0], nx = b.st[1];
        if (nloc == 0u) { xcd_barrier_complete(bar, b.x, nloc, nx); b.st[0] = nloc; b.st[1] = nx; }
        const unsigned old = xb_add(&bar[XB_SXSUB(b.x)], 1u);
        const unsigned gen = old / nloc;
        if (old + 1u == (gen + 1u) * nloc) {
            __builtin_amdgcn_fence(__ATOMIC_RELEASE, "agent");
            asm volatile("s_waitcnt vmcnt(0)" ::: "memory");
            const unsigned og = xb_add(&bar[XB_STOP], 1u);
            const unsigned tg = og / nx;
            if (og + 1u == (tg + 1u) * nx) xb_add(&bar[XB_SGEN], 1u);
        }
        b.st[2] = gen + 1u;
    }
}
__device__ __forceinline__ void xcd_split_wait(const XcdBarrier& b) {
    if (threadIdx.x == 0) {
        unsigned* bar = b.bar;
        const unsigned target = b.st[2];
        XB_SPIN(xb_ld(&bar[XB_SGEN]) < target, bar);
        __builtin_amdgcn_fence(__ATOMIC_ACQUIRE, "agent");
        asm volatile("s_waitcnt vmcnt(0)" ::: "memory");
    }
    __syncthreads();
}
__device__ __forceinline__ void xcd_barrier(const XcdBarrier& b) {
    asm volatile("s_waitcnt vmcnt(0)" ::: "memory");
    __syncthreads();
    if (threadIdx.x == 0) {
        unsigned* bar = b.bar;
        __builtin_amdgcn_s_waitcnt(0);
        unsigned nloc = b.st[0], nx = b.st[1];
        if (nloc == 0u) { xcd_barrier_complete(bar, b.x, nloc, nx); b.st[0] = nloc; b.st[1] = nx; }
        const unsigned old = xb_add(&bar[XB_XSUB(b.x)], 1u);
        const unsigned gen = old / nloc;
        if (old + 1u == (gen + 1u) * nloc) {
            __builtin_amdgcn_fence(__ATOMIC_RELEASE, "agent");
            asm volatile("s_waitcnt vmcnt(0)" ::: "memory");
            const unsigned og = xb_add(&bar[XB_TOP], 1u);
            const unsigned tg = og / nx;
            if (og + 1u == (tg + 1u) * nx) xb_add(&bar[XB_TOPGEN], 1u);
            else XB_SPIN(xb_ld(&bar[XB_TOPGEN]) == tg, bar);
            __builtin_amdgcn_fence(__ATOMIC_ACQUIRE, "agent");
            xb_add(&bar[XB_XGEN(b.x)], 1u);
            asm volatile("s_waitcnt vmcnt(0)" ::: "memory");
        } else {
            XB_SPIN(xb_ld(&bar[XB_XGEN(b.x)]) == gen, bar);
            __builtin_amdgcn_fence(__ATOMIC_ACQUIRE, "agent");
            asm volatile("s_waitcnt vmcnt(0)" ::: "memory");
        }
    }
    __syncthreads();
}


typedef short s16x4 __attribute__((ext_vector_type(4)));
#ifndef NA_NAIVE
#define NA_NAIVE 0
#endif
__device__ __forceinline__ int na_off(int row, int ch) { return row * 128 + ((ch ^ (row & 7)) << 4); }
__device__ __forceinline__ int off64(int row, int ch) { return row * 64 + ((ch ^ ((row >> 2) & 3)) << 4); }
__device__ __forceinline__ int doff(int row, int ch) { return row * 512 + ((ch ^ (row & 15)) << 4); }
#ifndef GLA_NAIVE
#define GLA_NAIVE 0
#endif
#ifndef POOL_NAIVE
#define POOL_NAIVE 0
#endif
__device__ __forceinline__ f32x4 na_qk(LAS unsigned char* kb, int krow, int lane, const bf16x8 qf0, const bf16x8 qf1, const f32x4 cin) {
    const int key = krow + (lane & 15), g = lane >> 4;
    const bf16x8 k0 = *(const LAS bf16x8*)(kb + na_off(key, g));
    const bf16x8 k1 = *(const LAS bf16x8*)(kb + na_off(key, 4 + g));
    f32x4 acc = __builtin_amdgcn_mfma_f32_16x16x32_bf16(k0, qf0, cin, 0, 0, 0);
    acc = __builtin_amdgcn_mfma_f32_16x16x32_bf16(k1, qf1, acc, 0, 0, 0);
    return acc;
}
__device__ __forceinline__ s16x4 na_tr(LAS unsigned char* p) { return __builtin_bit_cast(s16x4, __builtin_amdgcn_ds_read_tr16_b64_v4i16((LAS s16x4*)p)); }
__device__ __forceinline__ void na_pv(LAS unsigned char* vb, int kb0, int kb1, int lane, const bf16x8 pf, f32x4 (&o)[4]) {
    const int g = lane >> 4, q = (lane & 15) >> 2, p = lane & 3;
    const int r0 = kb0 + 4 * g + q, r1 = kb1 + 4 * g + q;
#pragma unroll
    for (int c = 0; c < 4; ++c) {
        const s16x4 lo = na_tr(vb + na_off(r0, 2 * c + (p >> 1)) + 8 * (p & 1));
        const s16x4 hi = na_tr(vb + na_off(r1, 2 * c + (p >> 1)) + 8 * (p & 1));
        const bf16x8 vf = (bf16x8){lo[0], lo[1], lo[2], lo[3], hi[0], hi[1], hi[2], hi[3]};
        o[c] = __builtin_amdgcn_mfma_f32_16x16x32_bf16(vf, pf, o[c], 0, 0, 0);
    }
}
__device__ __forceinline__ f32x4 na_qk_old(LAS unsigned char* kb, int krow, int lane, const bf16x8 qf0, const bf16x8 qf1) {
    const int key = krow + (lane & 15), g = lane >> 4;
    f32x4 acc = (f32x4){0.f, 0.f, 0.f, 0.f};
    const bf16x8 k0 = *(const LAS bf16x8*)(kb + na_off(key, g));
    const bf16x8 k1 = *(const LAS bf16x8*)(kb + na_off(key, 4 + g));
    acc = __builtin_amdgcn_mfma_f32_16x16x32_bf16(k0, qf0, acc, 0, 0, 0);
    acc = __builtin_amdgcn_mfma_f32_16x16x32_bf16(k1, qf1, acc, 0, 0, 0);
    return acc;
}
template <int NT>
__device__ __forceinline__ void na_softmax(f32x4 (&s)[NT], float& m, float& l, f32x4 (&o)[4], bf16x8 (&pf)[NT / 2]) {
    float mx = __builtin_elementwise_maximum(__builtin_elementwise_maximum(s[0][0], s[0][1]), s[0][2]);
    {   float m2 = s[0][3];
#pragma unroll
        for (int t = 1; t < NT; ++t) { m2 = __builtin_elementwise_maximum(__builtin_elementwise_maximum(m2, s[t][0]), s[t][1]); mx = __builtin_elementwise_maximum(__builtin_elementwise_maximum(mx, s[t][2]), s[t][3]); }
        mx = __builtin_elementwise_maximum(mx, m2); }
    mx = fmaxf(mx, __shfl_xor(mx, 16)); mx = fmaxf(mx, __shfl_xor(mx, 32));
    const float mn = fmaxf(m, mx);
    const float al = __builtin_amdgcn_exp2f(m - mn);
    m = mn;
    float sum = 0.f;
#pragma unroll
    for (int t = 0; t < NT; ++t)
#pragma unroll
        for (int i = 0; i < 4; ++i) { s[t][i] = __builtin_amdgcn_exp2f(s[t][i] - mn); sum += s[t][i]; }
    l = l * al + sum;
#pragma unroll
    for (int c = 0; c < 4; ++c) o[c] = o[c] * al;
#pragma unroll
    for (int t = 0; t < NT / 2; ++t) {
        const unsigned w0 = cvt_pk_bf16(s[2 * t][0], s[2 * t][1]), w1 = cvt_pk_bf16(s[2 * t][2], s[2 * t][3]);
        const unsigned w2 = cvt_pk_bf16(s[2 * t + 1][0], s[2 * t + 1][1]), w3 = cvt_pk_bf16(s[2 * t + 1][2], s[2 * t + 1][3]);
        pf[t] = __builtin_bit_cast(bf16x8, (u32x4){w0, w1, w2, w3});
    }
}


__device__ __forceinline__ void na_kfrag(LAS unsigned char* kb, int krow, int lane, bf16x8& k0, bf16x8& k1) {
    const int key = krow + (lane & 15), g = lane >> 4;
    k0 = *(const LAS bf16x8*)(kb + na_off(key, g)); k1 = *(const LAS bf16x8*)(kb + na_off(key, 4 + g));
}
__device__ __forceinline__ f32x4 na_qk2(const bf16x8 k0, const bf16x8 k1, const bf16x8 qf0, const bf16x8 qf1, const f32x4 cin) {
    f32x4 acc = __builtin_amdgcn_mfma_f32_16x16x32_bf16(k0, qf0, cin, 0, 0, 0);
    return __builtin_amdgcn_mfma_f32_16x16x32_bf16(k1, qf1, acc, 0, 0, 0);
}
__device__ __forceinline__ bf16x8 na_vfrag(LAS unsigned char* vb, int kb0, int kb1, int lane, int c) {
    const int g = lane >> 4, q = (lane & 15) >> 2, p = lane & 3;
    const s16x4 lo = na_tr(vb + na_off(kb0 + 4 * g + q, 2 * c + (p >> 1)) + 8 * (p & 1));
    const s16x4 hi = na_tr(vb + na_off(kb1 + 4 * g + q, 2 * c + (p >> 1)) + 8 * (p & 1));
    return (bf16x8){lo[0], lo[1], lo[2], lo[3], hi[0], hi[1], hi[2], hi[3]};
}
template <int NT>
__device__ __forceinline__ void na_sm(f32x4 (&s)[NT], f32x4& cinv, f32x4 (&mk)[2], const bool first, f32x4 (&o)[4], f32x4& osum, bf16x8 (&pf)[NT / 2], float& dl_out) {
    float mx = __builtin_elementwise_maximum(__builtin_elementwise_maximum(s[0][0], s[0][1]), s[0][2]);
    {   float m2 = s[0][3];
#pragma unroll
        for (int t = 1; t < NT; ++t) { m2 = __builtin_elementwise_maximum(__builtin_elementwise_maximum(m2, s[t][0]), s[t][1]); mx = __builtin_elementwise_maximum(__builtin_elementwise_maximum(mx, s[t][2]), s[t][3]); }
        mx = __builtin_elementwise_maximum(mx, m2); }
    dl_out = 0.f;
    if (first || __ballot(mx > 8.0f) != 0ull) {
        mx = fmaxf(mx, __shfl_xor(mx, 16)); mx = fmaxf(mx, __shfl_xor(mx, 32));
        const float dl = first ? mx : fmaxf(mx, 0.f);
        cinv = cinv - dl; mk[0] = mk[0] - dl; mk[1] = mk[1] - dl; dl_out = dl;
#pragma unroll
        for (int t = 0; t < NT; ++t) s[t] = s[t] - dl;
        if (!first) { const float al = __builtin_amdgcn_exp2f(-dl);
#pragma unroll
            for (int c = 0; c < 4; ++c) o[c] = o[c] * al;
            osum = osum * al; }
    }
#pragma unroll
    for (int t = 0; t < NT; ++t)
#pragma unroll
        for (int i = 0; i < 4; ++i) s[t][i] = __builtin_amdgcn_exp2f(s[t][i]);
#pragma unroll
    for (int t = 0; t < NT / 2; ++t) {
        const unsigned w0 = cvt_pk_bf16(s[2 * t][0], s[2 * t][1]), w1 = cvt_pk_bf16(s[2 * t][2], s[2 * t][3]);
        const unsigned w2 = cvt_pk_bf16(s[2 * t + 1][0], s[2 * t + 1][1]), w3 = cvt_pk_bf16(s[2 * t + 1][2], s[2 * t + 1][3]);
        pf[t] = __builtin_bit_cast(bf16x8, (u32x4){w0, w1, w2, w3});
    }
}
__device__ __forceinline__ void na_sm_pre2(f32x4 (&s)[2], f32x4& cinv, f32x4 (&mk)[2], const bool first, f32x4 (&o)[4], f32x4& osum) {
    float mx = __builtin_elementwise_maximum(__builtin_elementwise_maximum(s[0][0], s[0][1]), s[0][2]);
    {   float m2 = s[0][3];
        m2 = __builtin_elementwise_maximum(__builtin_elementwise_maximum(m2, s[1][0]), s[1][1]); mx = __builtin_elementwise_maximum(__builtin_elementwise_maximum(mx, s[1][2]), s[1][3]);
        mx = __builtin_elementwise_maximum(mx, m2); }
    if (first || __ballot(mx > 8.0f) != 0ull) {
        mx = fmaxf(mx, __shfl_xor(mx, 16)); mx = fmaxf(mx, __shfl_xor(mx, 32));
        const float dl = first ? mx : fmaxf(mx, 0.f);
        cinv = cinv - dl; mk[0] = mk[0] - dl; mk[1] = mk[1] - dl;
        s[0] = s[0] - dl; s[1] = s[1] - dl;
        if (!first) { const float al = __builtin_amdgcn_exp2f(-dl);
#pragma unroll
            for (int c = 0; c < 4; ++c) o[c] = o[c] * al;
            osum = osum * al; }
    }
}
__device__ __forceinline__ bf16x8 na_pack2(const f32x4 (&s)[2]) {
    const unsigned w0 = cvt_pk_bf16(s[0][0], s[0][1]), w1 = cvt_pk_bf16(s[0][2], s[0][3]);
    const unsigned w2 = cvt_pk_bf16(s[1][0], s[1][1]), w3 = cvt_pk_bf16(s[1][2], s[1][3]);
    return __builtin_bit_cast(bf16x8, (u32x4){w0, w1, w2, w3});
}

struct Args {
    const float* in[26]; float* out; unsigned char* ws; int ph_lo, ph_hi;
};
enum { I_XP = 0, I_XS, I_C, I_CK, I_CV, I_SF, I_SB, I_CCTX, I_WADA, I_BADA, I_G1, I_G2, I_WIN, I_WPOOL, I_PSCALE, I_QG, I_KG, I_RELB,
       I_WGF, I_BGF, I_WGB, I_BGB, I_GLAG, I_WOUT, I_WFFI, I_WFFO };

constexpr int LDS_BYTES = 147456, RING_BYTES = 131072, MISC_OFF = RING_BYTES + 320;

__device__ __forceinline__ void smallm_item(LAS float* Al, LAS float* red, const float* W, int ldw, int n0, int nvalid, const float* bias, float* out, int ldo) {
    int tid = threadIdx.x; asm volatile("" : "+v"(tid));
    const int lane = tid & 63, w = tid >> 6;
    const int n = n0 + 2 * lane; const bool ok = n < nvalid;
    float acc[NCOND][2];
#pragma unroll
    for (int c = 0; c < NCOND; ++c) { acc[c][0] = 0.f; acc[c][1] = 0.f; }
    const int k0 = w * 128;
    for (int kb = k0; kb < k0 + 128; kb += 8) {
        f32x2 wv[8];
#pragma unroll
        for (int j = 0; j < 8; ++j) { wv[j] = (f32x2){0.f, 0.f}; if (ok) wv[j] = *(const f32x2*)(W + (size_t)(kb + j) * ldw + n); }
#pragma unroll
        for (int j = 0; j < 8; ++j)
#pragma unroll
            for (int c = 0; c < NCOND; ++c) { const float a = Al[c * 1024 + kb + j]; acc[c][0] += a * wv[j].x; acc[c][1] += a * wv[j].y; }
    }
#pragma unroll
    for (int c = 0; c < NCOND; ++c) { red[(w * NCOND + c) * 128 + 2 * lane] = acc[c][0]; red[(w * NCOND + c) * 128 + 2 * lane + 1] = acc[c][1]; }
    __syncthreads();
    for (int o = tid; o < NCOND * 128; o += 512) { const int c = o >> 7, j = o & 127; float s = 0.f;
#pragma unroll
        for (int ww = 0; ww < 8; ++ww) s += red[(ww * NCOND + c) * 128 + j];
        const int nn = n0 + j; if (nn < nvalid) out[(size_t)c * ldo + nn] = s + (bias ? bias[nn] : 0.f); }
    __syncthreads();
}

__device__ __forceinline__ void smallm_item_dma(LAS unsigned char* lds, const float* W, int ldw, int n0, const float* bias, float* out, int ldo) {
    int tid = threadIdx.x; asm volatile("" : "+v"(tid));
    const int lane = tid & 63, w = __builtin_amdgcn_readfirstlane(tid >> 6);
    const LAS float* Al = (const LAS float*)lds; LAS float* red = (LAS float*)(lds + 36864);
    LAS unsigned char* ring = lds + (w < 7 ? 36864 + w * 12288 : 131072 + 1024);
    float acc[NCOND][2];
#pragma unroll
    for (int c = 0; c < NCOND; ++c) { acc[c][0] = 0.f; acc[c][1] = 0.f; }
    const int k0 = w * 128;
    const float* src = W + (size_t)(k0 + (lane >> 5)) * ldw + n0 + 4 * (lane & 31);
#define SMD_ISSUE(ch_) do { _Pragma("unroll") for (int i_ = 0; i_ < 4; ++i_) \
        __builtin_amdgcn_global_load_lds((const unsigned*)(src + (size_t)((ch_) * 8 + 2 * i_) * ldw), (LAS unsigned*)(ring + ((ch_) % 3) * 4096 + i_ * 1024), 16, 0, 0); } while (0)
    asm volatile("s_waitcnt vmcnt(0)" ::: "memory");
    SMD_ISSUE(0); SMD_ISSUE(1); SMD_ISSUE(2);
#pragma unroll 1
    for (int ch = 0; ch < 16; ++ch) {
        if (ch + 2 < 16) asm volatile("s_waitcnt vmcnt(8)" ::: "memory"); else if (ch + 1 < 16) asm volatile("s_waitcnt vmcnt(4)" ::: "memory"); else asm volatile("s_waitcnt vmcnt(0)" ::: "memory");
        const LAS unsigned char* cb = ring + (ch % 3) * 4096 + lane * 8;
        f32x2 wv[8];
#pragma unroll
        for (int j = 0; j < 8; ++j) wv[j] = *(const LAS f32x2*)(cb + j * 512);
#pragma unroll
        for (int j = 0; j < 8; ++j)
#pragma unroll
            for (int c = 0; c < NCOND; ++c) { const float a = Al[c * 1024 + k0 + ch * 8 + j]; acc[c][0] += a * wv[j].x; acc[c][1] += a * wv[j].y; }
        asm volatile("s_waitcnt lgkmcnt(0)" ::: "memory");
        if (ch + 3 < 16) SMD_ISSUE(ch + 3);
    }
#undef SMD_ISSUE
    __syncthreads();
#pragma unroll
    for (int c = 0; c < NCOND; ++c) { red[(w * NCOND + c) * 128 + 2 * lane] = acc[c][0]; red[(w * NCOND + c) * 128 + 2 * lane + 1] = acc[c][1]; }
    __syncthreads();
    for (int o = tid; o < NCOND * 128; o += 512) { const int c = o >> 7, j = o & 127; float sm = 0.f;
#pragma unroll
        for (int ww = 0; ww < 8; ++ww) sm += red[(ww * NCOND + c) * 128 + j];
        const int nn = n0 + j; out[(size_t)c * ldo + nn] = sm + (bias ? bias[nn] : 0.f); }
    __syncthreads();
}

__device__ __forceinline__ void transpose_item(const float* W, int ldw, int K, int nphys, bf16* Wt, int kind, int item, LAS float* scr, int lane) {
    const int npb = nphys / 32, kb = item / npb, pb = item % npb, k0 = 64 * kb, p0 = 32 * pb;
    const int g0 = lgroup(kind, p0);
    const bool rope = (kind == 0) && ((p0 >> 8) == 7);
    const int pl = plow(rope, lane & 31);
#pragma unroll 8
    for (int i = 0; i < 32; ++i) { const int kk = 2 * i + (lane >> 5); scr[kk * 33 + pl] = (g0 >= 0) ? W[(size_t)(k0 + kk) * ldw + g0 + (lane & 31)] : 0.f; }
    asm volatile("s_waitcnt lgkmcnt(0)" ::: "memory");
    const int c = lane & 7;
#pragma unroll
    for (int j = 0; j < 4; ++j) { const int n = (lane >> 3) + 8 * j; const LAS float* s = scr + (8 * c) * 33 + n;
        u32x4 o; o.x = cvt_pk_bf16(s[0 * 33], s[1 * 33]); o.y = cvt_pk_bf16(s[2 * 33], s[3 * 33]); o.z = cvt_pk_bf16(s[4 * 33], s[5 * 33]); o.w = cvt_pk_bf16(s[6 * 33], s[7 * 33]);
        *(u32x4*)(Wt + (size_t)(p0 + n) * K + k0 + 8 * c) = o; }
    asm volatile("s_waitcnt lgkmcnt(0)" ::: "memory");
}

constexpr int NPHASE = 2 + 7 * DEPTH;
__device__ __forceinline__ const float* inptr(const Args& a, int i) { asm volatile("" : "+s"(i)); return (const float*)(GAS const float*)a.in[i]; }

__global__ void __launch_bounds__(512, 2) fwd_kernel(Args args) {
    extern __shared__ __attribute__((aligned(16))) unsigned char lds_raw[];
    LAS unsigned char* lds = (LAS unsigned char*)lds_raw;
    LAS float* ldsf = (LAS float*)lds;
    const int wave0 = __builtin_amdgcn_readfirstlane(threadIdx.x >> 6);
    const int G = gridDim.x, bid = blockIdx.x;
    unsigned char* ws = args.ws;
    float* out = args.out;
    volatile LAS unsigned* MISC = (volatile LAS unsigned*)(lds + MISC_OFF);
    for (int u = threadIdx.x; u < (LDS_BYTES - RING_BYTES) / 4; u += 512) ((LAS unsigned*)(lds + RING_BYTES))[u] = 0u;
    __syncthreads();
    unsigned* ctl = (unsigned*)(ws + WS_CTL);
    XcdBarrier bar; bar.bar = ctl + CW_BAR; bar.x = 0; bar.st = nullptr;
#if MK_ONE_LAUNCH
    bar = xcd_barrier_post(ctl + CW_BAR, MISC + 8);
#endif
    const int lo = args.ph_lo, hi = args.ph_hi;
#define IN_PH(k) (lo <= (k) && (k) < hi)
#define SEAM(k) do { if (IN_PH(k) && IN_PH((k) + 1)) xcd_barrier(bar); } while (0)
#define SPLIT_ARRIVE(k) do { if (IN_PH(k) && IN_PH((k) + 1)) xcd_split_arrive(bar); } while (0)
#define SPLIT_WAIT(k) do { if (IN_PH(k) && IN_PH((k) + 1)) xcd_split_wait(bar); } while (0)

#define mods ((float*)(wsl + WS_MODS))
#define cva ((float*)(wsl + WS_CVA))
#define cvd ((float*)(wsl + WS_CVD))
#define wsc ((float*)(wsl + WS_WSC))
#define ropet ((float*)(wsl + WS_ROPE))
#define rowss ((float*)(wsl + WS_ROWSS))
#define Win_t ((bf16*)(wsl + WS_WIN))
#define Wout_t ((bf16*)(wsl + WS_WOUT))
#define Wffi_t ((bf16*)(wsl + WS_WFFI))
#define Wffo_t ((bf16*)(wsl + WS_WFFO))
#define XA ((bf16*)(wsl + WS_XA))
#define Y ((bf16*)(wsl + WS_Y))
#define H ((bf16*)(wsl + WS_H))
#define XR ((bf16*)(wsl + WS_XR))
#define Ub ((bf16*)(wsl + WS_U))
#define Qb ((bf16*)(wsl + WS_Q))
#define Kb ((bf16*)(wsl + WS_K))
#define Vb ((bf16*)(wsl + WS_V))
#define QLK ((bf16*)(wsl + WS_QLK))
#define VL ((bf16*)(wsl + WS_VL))
#define GS ((bf16*)(wsl + WS_GS))
#define LR ((float*)(wsl + WS_LR))
#define UF ((float*)(wsl + WS_UF))
#define UB ((float*)(wsl + WS_UB))
#define SINF ((float*)(wsl + WS_SINF))
#define SINB ((float*)(wsl + WS_SINB))
#define DF ((float*)(wsl + WS_DF))
#define DB ((float*)(wsl + WS_DB))
#define CKb ((bf16*)(wsl + WS_CK))
#define QKT ((bf16*)(wsl + WS_QKT))
#define STF ((bf16*)(wsl + WS_STF))
#define STB ((bf16*)(wsl + WS_STB))
#define WPT ((bf16*)(wsl + WS_WPT))
#define CVb ((bf16*)(wsl + WS_CV))

#define WSL GAS unsigned char* wsg_ = (GAS unsigned char*)ws; GAS float* outg_ = (GAS float*)out; int tid; asm volatile("v_mbcnt_lo_u32_b32 %0, -1, 0\n\tv_mbcnt_hi_u32_b32 %0, -1, %0" : "=v"(tid)); tid += wave0 * 64; asm volatile("" : "+s"(wsg_), "+s"(outg_), "+v"(tid)); unsigned char* wsl = (unsigned char*)wsg_; float* outl = (float*)outg_; const int lane = tid & 63, wave = __builtin_amdgcn_readfirstlane(tid >> 6); (void)lane; (void)wave;
#define INP(i) inptr(args, (i))
    for (int rep_ = 1 + ((REPEAT_MASK >> 0) & 1); rep_ > 0 && IN_PH(0); --rep_) { WSL
        LAS float* Al = ldsf; LAS float* red = ldsf + NCOND * 1024;
        bool filled = false;
        for (int it = bid; it < DEPTH * 48; it += G) {
            if (!filled) {
                for (int o = tid; o < NCOND * 1024; o += 512) { const int c = o >> 10, k = o & 1023; const float v = (c < 8) ? INP(I_C)[c * 1024 + k] : INP(I_CCTX)[k]; Al[o] = siluf(v); }
                __syncthreads(); filled = true;
            }
            const int l = it / 48, n0 = (it % 48) * 128;
            (void)red; smallm_item_dma(lds, INP(I_WADA) + (size_t)l * DM * 6144, 6144, n0, INP(I_BADA) + l * 6144, mods + (size_t)l * NCOND * 6144, 6144);
        }
        __syncthreads();
    }
    SPLIT_ARRIVE(0);
    for (int rep_ = 1 + ((REPEAT_MASK >> 1) & 1); rep_ > 0 && IN_PH(1); --rep_) { WSL
        const int gw = bid * 8 + wave, NGW = G * 8;
        {
            constexpr int I_A = 16 * (IN_WP / 32), I_C_ = 16 * 32, I_D = 16 * (FF2 / 32), I_E = (DFF / 64) * 32, I_L = I_A + I_C_ + I_D + I_E;
            LAS unsigned char* slot0 = lds + wave * 16384;
            struct TDesc { const float* src; bf16* dst; int K, kind, p0, g0, k0; };
            auto tdesc = [&](int it, TDesc& D) __attribute__((always_inline)) {
                const int l = it / I_L; int r = it % I_L; const float* W; int ldw, nphys;
                if (r < I_A) { W = INP(I_WIN) + (size_t)l * DM * IN_W; ldw = IN_W; D.K = DM; nphys = IN_WP; D.dst = Win_t + (size_t)l * IN_WP * DM; D.kind = 0; }
                else if ((r -= I_A) < I_C_) { W = INP(I_WOUT) + (size_t)l * DM * DM; ldw = DM; D.K = DM; nphys = DM; D.dst = Wout_t + (size_t)l * DM * DM; D.kind = 1; }
                else if ((r -= I_C_) < I_D) { W = INP(I_WFFI) + (size_t)l * DM * FF2; ldw = FF2; D.K = DM; nphys = FF2; D.dst = Wffi_t + (size_t)l * FF2 * DM; D.kind = 2; }
                else { r -= I_D; W = INP(I_WFFO) + (size_t)l * DFF * DM; ldw = DM; D.K = DFF; nphys = DM; D.dst = Wffo_t + (size_t)l * DM * DFF; D.kind = 1; }
                const int npb = nphys / 32, kb = r / npb, pb = r % npb; D.k0 = 64 * kb; D.p0 = 32 * pb; D.g0 = lgroup(D.kind, D.p0);
                D.src = W + (size_t)(D.k0 + (lane >> 3)) * ldw + (D.g0 >= 0 ? D.g0 : 0);
            };
            auto tissue = [&](int it, int sl) __attribute__((always_inline)) {
                const int l = it / I_L; int r = it % I_L; int ldw;
                if (r < I_A) ldw = IN_W; else if ((r -= I_A) < I_C_) ldw = DM; else if ((r -= I_C_) < I_D) ldw = FF2; else ldw = DM; (void)l;
                TDesc D; tdesc(it, D);
#pragma unroll
                for (int i = 0; i < 8; ++i) { const int ch = (lane & 7) ^ (((lane >> 3) + i) & 7);
                    __builtin_amdgcn_global_load_lds((const unsigned*)(D.src + (size_t)(8 * i) * ldw + 4 * ch), (LAS unsigned*)(slot0 + sl * 8192 + i * 1024), 16, 0, 0); }
            };
            const int nit = (DEPTH * I_L - gw + NGW - 1) / NGW;
            asm volatile("s_waitcnt vmcnt(0)" ::: "memory");
            if (nit > 0) tissue(gw, 0);
            if (nit > 1) tissue(gw + NGW, 1);
            for (int i = 0; i < nit; ++i) {
                const int it = gw + i * NGW;
                if (i + 1 < nit) asm volatile("s_waitcnt vmcnt(8)" ::: "memory"); else asm volatile("s_waitcnt vmcnt(0)" ::: "memory");
                TDesc D; tdesc(it, D);
                const bool rope = (D.kind == 0) && ((D.p0 >> 8) == 7);
                const LAS unsigned char* sb = slot0 + (i & 1) * 8192;
                const int c = lane & 7;
                u32x4 o[4];
#pragma unroll
                for (int j = 0; j < 4; ++j) { const int n = (lane >> 3) + 8 * j, l5 = llow5(rope, n);
                    float v[8];
#pragma unroll
                    for (int r8 = 0; r8 < 8; ++r8) v[r8] = *(const LAS float*)(sb + c * 1024 + r8 * 128 + (((l5 >> 2) ^ ((r8 + c) & 7)) << 4) + (l5 & 3) * 4);
                    if (D.g0 < 0) {
#pragma unroll
                        for (int r8 = 0; r8 < 8; ++r8) v[r8] = 0.f; }
                    o[j].x = cvt_pk_bf16(v[0], v[1]); o[j].y = cvt_pk_bf16(v[2], v[3]); o[j].z = cvt_pk_bf16(v[4], v[5]); o[j].w = cvt_pk_bf16(v[6], v[7]); }
                asm volatile("s_waitcnt lgkmcnt(0)" ::: "memory");
                if (i + 2 < nit) tissue(it + 2 * NGW, i & 1);
#pragma unroll
                for (int j = 0; j < 4; ++j) { const int n = (lane >> 3) + 8 * j; *(u32x4*)(D.dst + (size_t)(D.p0 + n) * D.K + D.k0 + 8 * c) = o[j]; }
            }
            asm volatile("s_waitcnt vmcnt(0)" ::: "memory");
        }
        if (bid == (G > 1 ? 1 : 0) && tid < 8) {
            const double th = ((tid & 1) ? 0.31622776601683794 : 1.0) * ((tid >> 1) == 0 ? 1.0 : ((tid >> 1) == 1 ? 0.1 : ((tid >> 1) == 2 ? 0.01 : 0.001)));
            double c1 = 1.0, s1 = 0.0; { double term = 1.0; double cs = 1.0, sn = 0.0; const double t2 = th * th;
                for (int k = 1; k <= 12; ++k) { term *= th / (2 * k - 1); sn += ((k & 1) ? term : -term); term *= th / (2 * k); cs += ((k & 1) ? -term : term); } c1 = cs; s1 = sn; (void)t2; }
            double c = 1.0, s = 0.0;
            for (int pos = 0; pos < 64; ++pos) { ropet[(pos * 8 + tid) * 2] = (float)c; ropet[(pos * 8 + tid) * 2 + 1] = (float)s; const double cn = c * c1 - s * s1, sn2 = s * c1 + c * s1; c = cn; s = sn2; }
        }
        for (int o = bid * 512 + tid; o < DEPTH * 4 * 64 * 64; o += G * 512) { const int c = o & 63, dd = (o >> 6) & 63, lg = o >> 12;
            WPT[o] = (bf16)(cvt_pk_bf16(INP(I_WPOOL)[((size_t)lg * 64 + c) * 64 + dd], 0.f) & 0xffffu); }
        for (size_t o = ((size_t)bid * 512 + tid) * 8; o < (size_t)2 * 4194304; o += (size_t)G * 512 * 8) {
            const bool isv = o >= 4194304; const size_t e = isv ? o - 4194304 : o;
            const float* s = (isv ? INP(I_CV) : INP(I_CK)) + e;
            const f32x4 a = *(const f32x4*)s, b = *(const f32x4*)(s + 4);
            *(u32x4*)((isv ? CVb : CKb) + e) = pack8(a, b);
        }
        SPLIT_WAIT(0);
        {
            LAS float* Al = ldsf; LAS float* red = ldsf + NCOND * 1024;
            for (int it = (bid + G - 96 % G) % G; it < DEPTH * 65; it += G) {
                const int l = it / 65, j = it % 65; const bool isA = j < 21;
                const int soff = isA ? 0 : 3 * 1024;
                for (int o = tid; o < NCOND * 1024; o += 512) { const int c = o >> 10, k = o & 1023; Al[o] = mods[((size_t)l * NCOND + c) * 6144 + soff + k]; }
                __syncthreads();
                if (isA) { if (j * 128 + 128 <= IN_W) smallm_item_dma(lds, INP(I_WIN) + (size_t)l * DM * IN_W, IN_W, j * 128, nullptr, cva + (size_t)l * NCOND * IN_WP, IN_WP);
                           else smallm_item(Al, red, INP(I_WIN) + (size_t)l * DM * IN_W, IN_W, j * 128, IN_W, nullptr, cva + (size_t)l * NCOND * IN_WP, IN_WP); }
                else smallm_item_dma(lds, INP(I_WFFI) + (size_t)l * DM * FF2, FF2, (j - 21) * 128, nullptr, cvd + (size_t)l * NCOND * FF2, FF2);
            }
            __syncthreads();
        }
        for (int o = bid * 512 + tid; o < DEPTH * 2 * NCOND * DM; o += G * 512) {
            const int col = o & 1023, c = (o >> 10) % NCOND, j = (o / (NCOND * DM)) & 1, l = o / (2 * NCOND * DM);
            const float gn = (j ? INP(I_G2) : INP(I_G1))[l * DM + col];
            wsc[o] = gn * (1.0f + mods[((size_t)l * NCOND + c) * 6144 + (j ? 4 : 1) * 1024 + col]);
        }
        for (int r0 = gw * 4; r0 < M; r0 += NGW * 4) {
            const float* g1 = INP(I_G1);
            f32x4 v[4][4]; const float* scp[4];
#pragma unroll
            for (int q = 0; q < 4; ++q) { const int r = r0 + q;
                const float* src = (r < M_CTX) ? INP(I_XP) + (size_t)r * DM : INP(I_XS) + (size_t)(r - M_CTX) * DM;
                const int ci = (r < M_CTX) ? 8 : ((r - M_CTX) >> 12); scp[q] = mods + (size_t)ci * 6144 + 1024;
#pragma unroll
                for (int j = 0; j < 4; ++j) v[q][j] = *(const f32x4*)(src + 4 * lane + 256 * j); }
#pragma unroll
            for (int q = 0; q < 4; ++q) { const int r = r0 + q; float ss = 0.f;
#pragma unroll
                for (int j = 0; j < 4; ++j) ss += (v[q][j][0] * v[q][j][0] + v[q][j][1] * v[q][j][1]) + (v[q][j][2] * v[q][j][2] + v[q][j][3] * v[q][j][3]);
                ss = wave_sum(ss);
                if (lane == 0) rowss[r] = ss;
#pragma unroll
                for (int j = 0; j < 4; ++j) { const int col = 4 * lane + 256 * j; const f32x4 s4 = *(const f32x4*)(scp[q] + col), g4 = *(const f32x4*)(g1 + col);
                    const f32x4 a = v[q][j] * g4 * (s4 + 1.0f); u32x2 w; w.x = cvt_pk_bf16(a[0], a[1]); w.y = cvt_pk_bf16(a[2], a[3]); *(u32x2*)(XA + (size_t)r * DM + col) = w; } }
        }
    }
    SEAM(1);

    for (int l = 0; l < DEPTH; ++l) {
        const int P = 2 + 7 * l;
        for (int rep_ = 1 + ((REPEAT_MASK >> 2) & 1); rep_ > 0 && IN_PH(P + 0); --rep_) { WSL
            pg8::Gemm g{XA, Win_t + (size_t)l * IN_WP * DM, M, IN_WP, DM}; pg8::StaticOrder S; S.init(M, IN_WP, G, bid, 1);
            EpiA E{l, wsl, outl, INP(I_QG) + l * 64, INP(I_KG) + l * 64};
            pg8::gemm_phase<EpiA, pg8::StaticOrder>(lds, g, S, E, tid);
            { pg8::Unit su; if (S.sub4(0, su)) { int t2_ = tid; asm volatile("" : "+v"(t2_)); pg8::gemm_sub4<EpiA>(lds, g, su, E, t2_); } }
        }
        SEAM(P + 0);
        LAS float* g_laf = ldsf;
        LAS float* g_lab = ldsf + 2048;
        LAS float* g_qf = ldsf + 4096;
        LAS float* g_kf = g_qf + 2112;
        LAS float* g_qb = g_kf + 2112;
        LAS float* g_kb = g_qb + 2112;
        LAS float* g_v = g_kb + 2112;
        LAS float* g_A = g_v + 4096;
        LAS float* g_sf = g_A + 4160;
        LAS float* g_sb = g_sf + 2048;
#define GLA_PREP(cidx, h) do { \
            const int row0_ = (cidx) * 64; \
            for (int idx = tid; idx < 4096; idx += 512) { const int dir = idx >> 11, t = (idx >> 5) & 63, d = idx & 31, col = (h) * 32 + d; \
                const float* wg = (dir ? INP(I_WGB) : INP(I_WGF)) + l * 16 * 128; float x = (dir ? INP(I_BGB) : INP(I_BGF))[l * 128 + col]; \
                const float* lr = LR + (size_t)(row0_ + t) * 32 + dir * 16; \
                _Pragma("unroll") for (int r = 0; r < 16; ++r) x += lr[r] * wg[r * 128 + col]; \
                const float ls = fminf(x, 0.f) - __logf(1.0f + __expf(-fabsf(x))); \
                (dir ? g_lab : g_laf)[t * 32 + d] = ls * (1.0f / 16.0f); } \
            __syncthreads(); \
            if (tid < 64) { const int d = tid & 31; float run = 0.f; \
                if (tid < 32) { for (int t = 0; t < 64; ++t) { run += g_laf[t * 32 + d]; g_laf[t * 32 + d] = run; } } \
                else { for (int t = 63; t >= 0; --t) { run += g_lab[t * 32 + d]; g_lab[t * 32 + d] = run; } } } \
            __syncthreads(); \
            for (int idx = tid; idx < 2048; idx += 512) { const int t = idx >> 5, d = idx & 31; \
                const float qv = bf2f(QLK[(size_t)(row0_ + t) * 256 + (h) * 32 + d]), kv = bf2f(QLK[(size_t)(row0_ + t) * 256 + 128 + (h) * 32 + d]); \
                const float bfv = g_laf[t * 32 + d], cbv = g_lab[t * 32 + d]; \
                g_qf[t * 33 + d] = qv * __expf(bfv); g_kf[t * 33 + d] = kv * __expf(-bfv); g_qb[t * 33 + d] = qv * __expf(cbv); g_kb[t * 33 + d] = kv * __expf(-cbv); } \
            for (int idx = tid; idx < 4096; idx += 512) { const int t = idx >> 6, dv = idx & 63; g_v[idx] = bf2f(VL[(size_t)(row0_ + t) * 256 + (h) * 64 + dv]); } \
            __syncthreads(); } while (0)
#if GLA_NAIVE
        for (int rep_ = 1 + ((REPEAT_MASK >> 3) & 1); rep_ > 0 && IN_PH(P + 1); --rep_) { WSL
            for (int it = bid; it < NCHUNK * 4; it += G) {
                const int cidx = it >> 2, h = it & 3;
                GLA_PREP(cidx, h);
                const int dk = tid >> 4, dv0 = (tid & 15) * 4;
                f32x4 af = (f32x4){0.f, 0.f, 0.f, 0.f}, ab = af;
                for (int s = 0; s < 64; ++s) { const float kfv = g_kf[s * 33 + dk], kbv = g_kb[s * 33 + dk]; const f32x4 vv = *(const LAS f32x4*)(g_v + s * 64 + dv0); af += vv * kfv; ab += vv * kbv; }
                const float ef = __expf(g_laf[63 * 32 + dk]), eb = __expf(g_lab[dk]);
                *(f32x4*)(UF + (size_t)it * 2048 + dk * 64 + dv0) = af * ef; *(f32x4*)(UB + (size_t)it * 2048 + dk * 64 + dv0) = ab * eb;
                if ((tid & 15) == 0) { DF[it * 32 + dk] = ef; DB[it * 32 + dk] = eb; }
                __syncthreads();
            }
        }
#else
        for (int rep_ = 1 + ((REPEAT_MASK >> 3) & 1); rep_ > 0 && IN_PH(P + 1); --rep_) { WSL
            const int dir = wave >> 2, h = wave & 3;
            for (int i = tid; i < 2 * 2048; i += 512) ((LAS float*)(lds + 66560))[i] = ((i >> 11) ? INP(I_WGB) : INP(I_WGF))[l * 2048 + (i & 2047)];
            for (int i = tid; i < 2 * 128; i += 512) ((LAS float*)(lds + 82944))[i] = ((i >> 7) ? INP(I_BGB) : INP(I_BGF))[l * 128 + (i & 127)];
            __syncthreads();
            const LAS float* gwl = (const LAS float*)(lds + 66560) + dir * 2048 + h * 32;
            const LAS float* gbl = (const LAS float*)(lds + 82944) + dir * 128 + h * 32;
            LAS unsigned char* kimg = lds + (dir * 4 + h) * 4096;
            LAS unsigned char* vimg = lds + 32768 + h * 8192;
            LAS float* tot = (LAS float*)(lds + 65536) + (dir * 4 + h) * 32;
            const int lane_g1 = lane;
            for (int cidx = (bid + G / 2) % G; cidx < NCHUNK; cidx += G) {
                int lane = lane_g1; asm volatile("" : "+v"(lane));
                const int g = lane >> 4, q4 = (lane & 15) >> 2, p4 = lane & 3;
                const int row0 = cidx * 64, c16 = lane & 15;
                u32x2 qwv[4][2], kwv[4][2]; u32x4 vst[4];
#pragma unroll
                for (int tt = 0; tt < 4; ++tt)
#pragma unroll
                    for (int dt = 0; dt < 2; ++dt) { const int t = 16 * tt + c16, d0 = 16 * dt + 4 * g;
                        qwv[tt][dt] = *(const u32x2*)(QLK + (size_t)(row0 + t) * 256 + h * 32 + d0); kwv[tt][dt] = *(const u32x2*)(QLK + (size_t)(row0 + t) * 256 + 128 + h * 32 + d0); }
                {   const int vrow = 32 * dir + (lane >> 1), part = lane & 1;
                    const u32x4* vp = (const u32x4*)(VL + (size_t)(row0 + vrow) * 256 + h * 64 + part * 32);
#pragma unroll
                    for (int c4 = 0; c4 < 4; ++c4) vst[c4] = vp[c4]; }
                bf16x8 a1[2], a2[2]; f32x4 bia[2];
#pragma unroll
                for (int dt = 0; dt < 2; ++dt) { unsigned hi[4], lo[4];
#pragma unroll
                    for (int j2 = 0; j2 < 4; ++j2) { const float w0 = gwl[(8 * (g & 1) + 2 * j2) * 128 + 16 * dt + c16], w1 = gwl[(8 * (g & 1) + 2 * j2 + 1) * 128 + 16 * dt + c16];
                        hi[j2] = cvt_pk_bf16(w0, w1); lo[j2] = cvt_pk_bf16(w0 - bflo(hi[j2]), w1 - bfhi(hi[j2])); }
                    a1[dt] = __builtin_bit_cast(bf16x8, (u32x4){hi[0], hi[1], hi[2], hi[3]}); a2[dt] = __builtin_bit_cast(bf16x8, (u32x4){lo[0], lo[1], lo[2], lo[3]});
                    bia[dt] = *(const LAS f32x4*)(gbl + 16 * dt + 4 * g); }
                f32x4 xg[4][2];
#pragma unroll
                for (int tt = 0; tt < 4; ++tt) {
                    const f32x4* lp = (const f32x4*)(LR + (size_t)(row0 + 16 * tt + c16) * 32 + dir * 16 + 8 * (g & 1));
                    const f32x4 l0 = lp[0], l1 = lp[1];
                    unsigned hi[4], lo[4];
                    hi[0] = cvt_pk_bf16(l0[0], l0[1]); hi[1] = cvt_pk_bf16(l0[2], l0[3]); hi[2] = cvt_pk_bf16(l1[0], l1[1]); hi[3] = cvt_pk_bf16(l1[2], l1[3]);
                    lo[0] = cvt_pk_bf16(l0[0] - bflo(hi[0]), l0[1] - bfhi(hi[0])); lo[1] = cvt_pk_bf16(l0[2] - bflo(hi[1]), l0[3] - bfhi(hi[1]));
                    lo[2] = cvt_pk_bf16(l1[0] - bflo(hi[2]), l1[1] - bfhi(hi[2])); lo[3] = cvt_pk_bf16(l1[2] - bflo(hi[3]), l1[3] - bfhi(hi[3]));
                    const bool uh = g < 2;
                    const bf16x8 bfr = __builtin_bit_cast(bf16x8, (u32x4){uh ? hi[0] : lo[0], uh ? hi[1] : lo[1], uh ? hi[2] : lo[2], uh ? hi[3] : lo[3]});
#pragma unroll
                    for (int dt = 0; dt < 2; ++dt) { f32x4 acc = __builtin_amdgcn_mfma_f32_16x16x32_bf16(a1[dt], bfr, bia[dt], 0, 0, 0);
                        xg[tt][dt] = __builtin_amdgcn_mfma_f32_16x16x32_bf16(a2[dt], bfr, acc, 0, 0, 0); }
                }
#pragma unroll
                for (int tt = 0; tt < 4; ++tt)
#pragma unroll
                    for (int dt = 0; dt < 2; ++dt)
#pragma unroll
                        for (int i = 0; i < 4; ++i) { const float x = xg[tt][dt][i]; xg[tt][dt][i] = (fminf(x, 0.f) - __logf(1.0f + __expf(-fabsf(x)))) * (1.0f / 16.0f); }
#pragma unroll
                for (int dt = 0; dt < 2; ++dt)
#pragma unroll
                    for (int i = 0; i < 4; ++i) {
                        float carry = 0.f;
#pragma unroll
                        for (int tq = 0; tq < 4; ++tq) { const int tt = dir ? 3 - tq : tq;
                            float v = xg[tt][dt][i], tot = v;
                            if (dir == 0) { v += dpp0<0x111>(v); v += dpp0<0x112>(v); v += dpp0<0x114>(v); v += dpp0<0x118>(v); }
                            else { v += dpp0<0x101>(v); v += dpp0<0x102>(v); v += dpp0<0x104>(v); v += dpp0<0x108>(v); }
                            tot += dpp0<0x128>(tot); tot += dpp0<0x124>(tot); tot += dpp0<0x122>(tot); tot += dpp0<0x121>(tot);
                            xg[tt][dt][i] = v + carry; carry += tot; }
                        if (c16 == 0) tot[16 * dt + 4 * g + i] = carry;
                    }
                bf16* qo = QKT + (size_t)row0 * 512 + dir * 256 + h * 32; bf16* ko = qo + 128;
#pragma unroll
                for (int tt = 0; tt < 4; ++tt)
#pragma unroll
                    for (int dt = 0; dt < 2; ++dt) {
                        const int t = 16 * tt + c16, d0 = 16 * dt + 4 * g;
                        const u32x2 qw = qwv[tt][dt], kw = kwv[tt][dt];
                        float e[4], en[4];
#pragma unroll
                        for (int i = 0; i < 4; ++i) { e[i] = __expf(xg[tt][dt][i]); en[i] = __expf(-xg[tt][dt][i]); }
                        u32x2 qv, kv;
                        qv.x = cvt_pk_bf16(bflo(qw.x) * e[0], bfhi(qw.x) * e[1]); qv.y = cvt_pk_bf16(bflo(qw.y) * e[2], bfhi(qw.y) * e[3]);
                        kv.x = cvt_pk_bf16(bflo(kw.x) * en[0], bfhi(kw.x) * en[1]); kv.y = cvt_pk_bf16(bflo(kw.y) * en[2], bfhi(kw.y) * en[3]);
                        *(u32x2*)(qo + (size_t)t * 512 + d0) = qv; *(u32x2*)(ko + (size_t)t * 512 + d0) = kv;
                        *(LAS u32x2*)(kimg + off64(t, 2 * dt + (g >> 1)) + 8 * (g & 1)) = kv;
                    }
                {
                    const int vrow = 32 * dir + (lane >> 1), part = lane & 1;
#pragma unroll
                    for (int c4 = 0; c4 < 4; ++c4) *(LAS u32x4*)(vimg + na_off(vrow, part * 4 + c4)) = vst[c4];
                }
                __syncthreads();
                f32x4 u[2][4];
#pragma unroll
                for (int a = 0; a < 2; ++a)
#pragma unroll
                    for (int b = 0; b < 4; ++b) u[a][b] = (f32x4){0.f, 0.f, 0.f, 0.f};
#pragma unroll
                for (int ks = 0; ks < 2; ++ks) {
                    const int tr0 = 32 * ks + 8 * g + q4, tr1 = tr0 + 4;
                    bf16x8 af[2], bfv[4];
#pragma unroll
                    for (int dkt = 0; dkt < 2; ++dkt) { const s16x4 lo = na_tr(kimg + off64(tr0, 2 * dkt + (p4 >> 1)) + 8 * (p4 & 1)), hi = na_tr(kimg + off64(tr1, 2 * dkt + (p4 >> 1)) + 8 * (p4 & 1));
                        af[dkt] = (bf16x8){lo[0], lo[1], lo[2], lo[3], hi[0], hi[1], hi[2], hi[3]}; }
#pragma unroll
                    for (int dvt = 0; dvt < 4; ++dvt) { const s16x4 lo = na_tr(vimg + na_off(tr0, 2 * dvt + (p4 >> 1)) + 8 * (p4 & 1)), hi = na_tr(vimg + na_off(tr1, 2 * dvt + (p4 >> 1)) + 8 * (p4 & 1));
                        bfv[dvt] = (bf16x8){lo[0], lo[1], lo[2], lo[3], hi[0], hi[1], hi[2], hi[3]}; }
#pragma unroll
                    for (int dkt = 0; dkt < 2; ++dkt)
#pragma unroll
                        for (int dvt = 0; dvt < 4; ++dvt) u[dkt][dvt] = __builtin_amdgcn_mfma_f32_16x16x32_bf16(bfv[dvt], af[dkt], u[dkt][dvt], 0, 0, 0);
                }
                {   const size_t item = (size_t)cidx * 4 + h; float* Uo = (dir ? UB : UF) + item * 2048; float* Do = (dir ? DB : DF) + item * 32;
#pragma unroll
                    for (int dkt = 0; dkt < 2; ++dkt) { const int dk = 16 * dkt + (lane & 15); const float ef = __expf(tot[dk]);
#pragma unroll
                        for (int dvt = 0; dvt < 4; ++dvt) *(f32x4*)(Uo + dk * 64 + 16 * dvt + 4 * g) = u[dkt][dvt] * ef;
                        if (g == 0) Do[dk] = ef; }
                }
                __syncthreads();
            }
        }
#endif
        SPLIT_ARRIVE(P + 1);
        for (int rep_ = 1 + ((REPEAT_MASK >> 3) & 1); rep_ > 0 && IN_PH(P + 1); --rep_) { WSL
#if POOL_NAIVE
            {
                LAS float* dbuf = ldsf;
                const float* wp = INP(I_WPOOL) + (size_t)l * 4 * 64 * 64; const float* psc = INP(I_PSCALE) + l * 256;
                for (int it = bid; it < M / 32; it += G) {
                    const int row0 = it * 32;
                    int seq0, L; if (row0 < M_CTX) { seq0 = row0 & ~255; L = 256; } else { seq0 = M_CTX + ((row0 - M_CTX) & ~4095); L = 4096; }
                    {   const int c = tid & 255, half = tid >> 8, g = c >> 6, hw = 1 << g;
                        for (int tt = half * 16; tt < half * 16 + 16; ++tt) {
                            const int t = row0 + tt - seq0; const int a = max(t - hw, 0), b = min(t + hw, L);
                            float s = 0.f; for (int q = a; q < b; ++q) s += bf2f(Ub[(size_t)(seq0 + q) * 256 + c]);
                            dbuf[tt * 256 + c] = s / (float)(b - a) - bf2f(Ub[(size_t)(row0 + tt) * 256 + c]);
                        } }
                    __syncthreads();
                    {   const int oc = tid & 255, g = oc >> 6, dd = oc & 63, th = tid >> 8;
                        float acc[16];
#pragma unroll
                        for (int j = 0; j < 16; ++j) acc[j] = 0.f;
                        for (int c = 0; c < 64; ++c) { const float w = wp[(g * 64 + c) * 64 + dd];
#pragma unroll
                            for (int j = 0; j < 16; ++j) acc[j] += dbuf[(th + 2 * j) * 256 + g * 64 + c] * w; }
                        const float sc = psc[oc];
#pragma unroll
                        for (int j = 0; j < 16; ++j) Y[(size_t)(row0 + th + 2 * j) * DM + oc] = (bf16)(cvt_pk_bf16(acc[j] * sc, 0.f) & 0xffffu);
                    }
                    __syncthreads();
                }
            }
#else
            {
                const bf16* WPTl = WPT + (size_t)l * 4 * 64 * 64; const float* psc = INP(I_PSCALE) + l * 256;
                LAS unsigned char* dimg = lds + 40960;
                const int tid_pl = tid;
#define POOL_DMA(it_, buf_) do { const int row0_ = (it_) * 64; int seq0_, L_; if (row0_ < M_CTX) { seq0_ = row0_ & ~255; L_ = 256; } else { seq0_ = M_CTX + ((row0_ - M_CTX) & ~4095); L_ = 4096; } \
                    int tf_ = tid_pl; asm volatile("" : "+v"(tf_)); \
                    _Pragma("unroll") for (int j_ = 0; j_ < 5; ++j_) { const int idx_ = tf_ + 512 * j_, rowl_ = idx_ >> 5, ch_ = idx_ & 31, ts_ = min(max(row0_ - seq0_ - 8 + rowl_, 0), L_ - 1); \
                        __builtin_amdgcn_global_load_lds((const unsigned*)(Ub + (size_t)(seq0_ + ts_) * 256 + ch_ * 8), (LAS unsigned*)(lds + (buf_) + (j_ * 512 + wave * 64) * 16), 16, 0, 0); } } while (0)
                int pbuf = 0;
                if (bid < NCHUNK) POOL_DMA(bid, 0);
                for (int it = bid; it < NCHUNK; it += G) {
                    int tid = tid_pl; asm volatile("" : "+v"(tid)); const int lane = tid & 63, g = lane >> 4;
                    const int row0 = it * 64;
                    int seq0, L; if (row0 < M_CTX) { seq0 = row0 & ~255; L = 256; } else { seq0 = M_CTX + ((row0 - M_CTX) & ~4095); L = 4096; }
                    const int tpos0 = row0 - seq0;
                    LAS unsigned char* ubuf = lds + pbuf;
                    asm volatile("s_waitcnt vmcnt(0)" ::: "memory");
                    __syncthreads();
                    if (tpos0 == 0 || tpos0 + 64 == L) {
                        for (int idx = tid; idx < 8 * 32; idx += 512) { const int rowl = (tpos0 == 0 ? 0 : 72) + (idx >> 5), ch = idx & 31; *(LAS u32x4*)(ubuf + rowl * 512 + ch * 16) = (u32x4){0u, 0u, 0u, 0u}; }
                        __syncthreads();
                    }
                    if (it + G < NCHUNK) POOL_DMA(it + G, pbuf ? 0 : 73728);
                    {   const int c = tid & 255, thalf = tid >> 8, grp = c >> 6, hw = 1 << grp;
                        const LAS bf16* uc = (const LAS bf16*)ubuf + c;
                        const int t0 = 32 * thalf;
                        float s = 0.f;
                        for (int j = -hw; j < hw; ++j) s += bf2f(uc[(t0 + 8 + j) * 256]);
                        for (int t = t0; t < t0 + 32; ++t) {
                            const int tp = tpos0 + t; const int cnt = min(tp + hw, L) - max(tp - hw, 0);
                            const float uv = bf2f(uc[(t + 8) * 256]);
                            const float d = s * __builtin_amdgcn_rcpf((float)cnt) - uv;
                            *(LAS bf16*)(dimg + doff(t, c >> 3) + (c & 7) * 2) = (bf16)(cvt_pk_bf16(d, 0.f) & 0xffffu);
                            s += bf2f(uc[(t + 8 + hw) * 256]) - bf2f(uc[(t + 8 - hw) * 256]);
                        } }
                    __syncthreads();
                    {   const int grp = wave >> 1, thh = wave & 1;
#pragma unroll
                        for (int ttl = 0; ttl < 2; ++ttl) {
                            const int trow = 16 * (2 * thh + ttl) + (lane & 15);
                            bf16x8 bfr[2];
#pragma unroll
                            for (int ks = 0; ks < 2; ++ks) bfr[ks] = *(const LAS bf16x8*)(dimg + doff(trow, 8 * grp + 4 * ks + g));
#pragma unroll
                            for (int ddt = 0; ddt < 4; ++ddt) {
                                f32x4 acc = (f32x4){0.f, 0.f, 0.f, 0.f};
#pragma unroll
                                for (int ks = 0; ks < 2; ++ks) { const bf16x8 a = *(const bf16x8*)(WPTl + (size_t)(grp * 64 + 16 * ddt + (lane & 15)) * 64 + 32 * ks + 8 * g);
                                    acc = __builtin_amdgcn_mfma_f32_16x16x32_bf16(a, bfr[ks], acc, 0, 0, 0); }
                                const int dd = grp * 64 + 16 * ddt + 4 * g;
                                const f32x4 sc = *(const f32x4*)(psc + dd);
                                u32x2 w; w.x = cvt_pk_bf16(acc[0] * sc[0], acc[1] * sc[1]); w.y = cvt_pk_bf16(acc[2] * sc[2], acc[3] * sc[3]);
                                *(u32x2*)(Y + (size_t)(row0 + trow) * DM + dd) = w;
                            }
                        } }
                    pbuf = pbuf ? 0 : 73728;
                }
                asm volatile("s_waitcnt vmcnt(0)" ::: "memory");
                __syncthreads();
#undef POOL_DMA
            }
#endif
        }
        SPLIT_WAIT(P + 1);
        for (int rep_ = 1 + ((REPEAT_MASK >> 4) & 1); rep_ > 0 && IN_PH(P + 2); --rep_) { WSL
            for (int it = (bid + G - G / 4) % G; it < 24 * 4 * 2; it += G) {
                const int dir = it & 1, h = (it >> 1) & 3, seq = it >> 3;
                const int e = tid * 4, dk = tid >> 4;
                int chunk0, N; f32x4 S = (f32x4){0.f, 0.f, 0.f, 0.f};
                if (seq < 16) { chunk0 = seq * 4; N = 4; }
                else { const int b = seq - 16; chunk0 = 64 + b * 64; N = 64; S = *(const f32x4*)((dir ? INP(I_SB) : INP(I_SF)) + (size_t)((b * 2 + l) * 4 + h) * 2048 + e); }
                const float* Uu = dir ? UB : UF; const float* Dd = dir ? DB : DF; float* Si = dir ? SINB : SINF; (void)Si;
#if GLA_NAIVE
#define SCAN_STORE(itx_) *(f32x4*)(Si + (itx_) * 2048 + e) = S
#else
#define SCAN_STORE(itx_) do { u32x2 w_; w_.x = cvt_pk_bf16(S[0], S[1]); w_.y = cvt_pk_bf16(S[2], S[3]); *(u32x2*)((dir ? STB : STF) + (itx_) * 2048 + e) = w_; } while (0)
#endif
#define SCAN_BLOCK(NB) do { f32x4 ub_[NB]; float db_[NB]; \
                    _Pragma("unroll") for (int j = 0; j < NB; ++j) { const int ch = dir ? (chunk0 + N - 1 - (n0 + j)) : (chunk0 + n0 + j); const size_t itx = (size_t)ch * 4 + h; db_[j] = Dd[itx * 32 + dk]; ub_[j] = *(const f32x4*)(Uu + itx * 2048 + e); } \
                    _Pragma("unroll") for (int j = 0; j < NB; ++j) { const int ch = dir ? (chunk0 + N - 1 - (n0 + j)) : (chunk0 + n0 + j); const size_t itx = (size_t)ch * 4 + h; SCAN_STORE(itx); S = S * db_[j] + ub_[j]; } } while (0)
                if (N == 4) { const int n0 = 0; SCAN_BLOCK(4); }
                else {
#pragma unroll 1
                    for (int n0 = 0; n0 < N; n0 += 16) { SCAN_BLOCK(16); }
                }
#undef SCAN_BLOCK
#undef SCAN_STORE
                if (seq < 16) *(f32x4*)(outl + (dir ? OUT_GB : OUT_GF) + (size_t)((seq * 2 + l) * 4 + h) * 2048 + e) = S;
            }
        }
        SPLIT_ARRIVE(P + 2);
        for (int rep_ = 1 + ((REPEAT_MASK >> 10) & 1); rep_ > 0 && IN_PH(P + 3); --rep_) { WSL
#if NA_NAIVE
            for (int it = bid; it < 128 + 1024; it += G) {
                const int half = tid & 1, qi = tid >> 1;
                float q[32], o[32]; float mx = -INFINITY, ls = 0.f;
#pragma unroll
                for (int d = 0; d < 32; ++d) o[d] = 0.f;
                int rowq, h;
#define NA_KEY(kp_is_f32, kptr, vptr, sbias) do { \
                    float s_ = 0.f; \
                    if (kp_is_f32) { const f32x4* k4 = (const f32x4*)((const float*)(kptr) + 32 * half); _Pragma("unroll") for (int d4 = 0; d4 < 8; ++d4) { const f32x4 kk = k4[d4]; s_ += q[4 * d4] * kk[0] + q[4 * d4 + 1] * kk[1] + q[4 * d4 + 2] * kk[2] + q[4 * d4 + 3] * kk[3]; } } \
                    else { const u32x4* k8 = (const u32x4*)((const bf16*)(kptr) + 32 * half); _Pragma("unroll") for (int d8 = 0; d8 < 4; ++d8) { const u32x4 kk = k8[d8]; \
                        s_ += q[8 * d8] * bflo(kk.x) + q[8 * d8 + 1] * bfhi(kk.x) + q[8 * d8 + 2] * bflo(kk.y) + q[8 * d8 + 3] * bfhi(kk.y) + q[8 * d8 + 4] * bflo(kk.z) + q[8 * d8 + 5] * bfhi(kk.z) + q[8 * d8 + 6] * bflo(kk.w) + q[8 * d8 + 7] * bfhi(kk.w); } } \
                    s_ += __shfl_xor(s_, 1); s_ += (sbias); \
                    const float mn_ = fmaxf(mx, s_); const float al_ = __builtin_amdgcn_exp2f(mx - mn_), p_ = __builtin_amdgcn_exp2f(s_ - mn_); mx = mn_; ls = ls * al_ + p_; \
                    if (kp_is_f32) { const f32x4* v4 = (const f32x4*)((const float*)(vptr) + 32 * half); _Pragma("unroll") for (int d4 = 0; d4 < 8; ++d4) { const f32x4 vv = v4[d4]; o[4 * d4] = o[4 * d4] * al_ + p_ * vv[0]; o[4 * d4 + 1] = o[4 * d4 + 1] * al_ + p_ * vv[1]; o[4 * d4 + 2] = o[4 * d4 + 2] * al_ + p_ * vv[2]; o[4 * d4 + 3] = o[4 * d4 + 3] * al_ + p_ * vv[3]; } } \
                    else { const u32x4* v8 = (const u32x4*)((const bf16*)(vptr) + 32 * half); _Pragma("unroll") for (int d8 = 0; d8 < 4; ++d8) { const u32x4 vv = v8[d8]; \
                        o[8 * d8] = o[8 * d8] * al_ + p_ * bflo(vv.x); o[8 * d8 + 1] = o[8 * d8 + 1] * al_ + p_ * bfhi(vv.x); o[8 * d8 + 2] = o[8 * d8 + 2] * al_ + p_ * bflo(vv.y); o[8 * d8 + 3] = o[8 * d8 + 3] * al_ + p_ * bfhi(vv.y); \
                        o[8 * d8 + 4] = o[8 * d8 + 4] * al_ + p_ * bflo(vv.z); o[8 * d8 + 5] = o[8 * d8 + 5] * al_ + p_ * bfhi(vv.z); o[8 * d8 + 6] = o[8 * d8 + 6] * al_ + p_ * bflo(vv.w); o[8 * d8 + 7] = o[8 * d8 + 7] * al_ + p_ * bfhi(vv.w); } } \
                } while (0)
#define NA_LOADQ() do { const u32x4* q8 = (const u32x4*)(Qb + (size_t)rowq * 512 + h * 64 + 32 * half); \
                    _Pragma("unroll") for (int d8 = 0; d8 < 4; ++d8) { const u32x4 w_ = q8[d8]; q[8 * d8] = bflo(w_.x); q[8 * d8 + 1] = bfhi(w_.x); q[8 * d8 + 2] = bflo(w_.y); q[8 * d8 + 3] = bfhi(w_.y); q[8 * d8 + 4] = bflo(w_.z); q[8 * d8 + 5] = bfhi(w_.z); q[8 * d8 + 6] = bflo(w_.w); q[8 * d8 + 7] = bfhi(w_.w); } } while (0)
                if (it < 128) {
                    const int b = it >> 3; h = it & 7; rowq = b * 256 + qi;
                    NA_LOADQ();
                    for (int j = 0; j < 256; ++j) { const size_t kr = (size_t)(b * 256 + j) * 512 + h * 64; NA_KEY(false, Kb + kr, Vb + kr, 0.f); }
                } else {
                    const int u = it - 128, b = u >> 7; h = (u >> 4) & 7; const int R4 = u & 15;
                    const int r = R4 * 4 + (qi >> 6), c = qi & 63; rowq = M_CTX + b * 4096 + r * 64 + c;
                    NA_LOADQ();
                    const int rs0 = min(max(r - 4, 0), 56), cs0 = min(max(c - 8, 0), 48);
                    const float* rb = INP(I_RELB) + (size_t)(l * 8 + h) * 15 * 31;
                    for (int i = 0; i < 8; ++i) { const int kr_ = rs0 + i;
                        for (int kc = 0; kc < 64; ++kc) {
                            if (kc >= cs0 && kc < cs0 + 16) {
                                const size_t kr = (size_t)(M_CTX + b * 4096 + kr_ * 64 + kc) * 512 + h * 64;
                                const float bias = rb[(kr_ - r + 7) * 31 + (kc - c + 15)] * LOG2E;
                                NA_KEY(false, Kb + kr, Vb + kr, bias);
                            } } }
                    const float* ck = INP(I_CK) + (size_t)((b * 2 + l) * 8 + h) * 512 * 64; const float* cvp = INP(I_CV) + (size_t)((b * 2 + l) * 8 + h) * 512 * 64;
                    for (int n = 0; n < 512; ++n) { NA_KEY(true, ck + (size_t)n * 64, cvp + (size_t)n * 64, 0.f); }
                }
                const float inv = 1.0f / ls;
                u32x4* yo = (u32x4*)(Y + (size_t)rowq * DM + 256 + h * 64 + 32 * half);
#pragma unroll
                for (int d8 = 0; d8 < 4; ++d8) { u32x4 w; w.x = cvt_pk_bf16(o[8 * d8] * inv, o[8 * d8 + 1] * inv); w.y = cvt_pk_bf16(o[8 * d8 + 2] * inv, o[8 * d8 + 3] * inv); w.z = cvt_pk_bf16(o[8 * d8 + 4] * inv, o[8 * d8 + 5] * inv); w.w = cvt_pk_bf16(o[8 * d8 + 6] * inv, o[8 * d8 + 7] * inv); yo[d8] = w; }
#undef NA_KEY
#undef NA_LOADQ
            }
#else
            {
                LAS unsigned char* nl = lds;
                LAS float* btab = (LAS float*)(lds + 32768);
                const int vcu = (bid & 7) * (G >> 3) + (bid >> 3);
                const int tid_na = tid;
                int h_tab = -1;
                if (wave >= 4) __builtin_amdgcn_s_setprio(1);
                u32x4 kreg; bool pre0 = false;
                for (int it0 = 0; it0 < 1280; it0 += G) {
                    int tid = tid_na; asm volatile("" : "+v"(tid)); const int lane = tid & 63;
                    const int g = lane >> 4, qc = lane & 15;
                    const int srow = tid >> 3, sch = tid & 7;
                    const int sdst = na_off(srow, sch);
                    const int it = it0 + ((G & 7) == 0 ? vcu : bid);
                    if (it >= 1280) break;
                    const bool lat = it < 1024;
                    int b, h, r0 = 0, half = 0;
                    if (lat) { b = it >> 7; h = (it >> 4) & 7; r0 = (it & 15) * 4; } else { const int u = it - 1024; b = u >> 4; h = (u >> 1) & 7; half = u & 1; }
                    const int lo = lat ? min(max(r0 - 4, 0), 56) : 0, hi = lat ? (min(max(r0 - 1, 0), 56) + 8) : 0;
                    const int nctx = lat ? 8 : 4, ntile = nctx + (hi - lo);
                    const bf16* kc_base; const bf16* vc_base; int cpitch;
                    if (lat) { kc_base = CKb + (size_t)((b * 2 + l) * 8 + h) * 512 * 64; vc_base = CVb + (size_t)((b * 2 + l) * 8 + h) * 512 * 64; cpitch = 64; }
                    else { kc_base = Kb + (size_t)(b * 256) * 512 + h * 64; vc_base = Vb + (size_t)(b * 256) * 512 + h * 64; cpitch = 512; }
                    const bf16* kl_base = Kb + (size_t)(M_CTX + b * 4096) * 512 + h * 64; const bf16* vl_base = Vb + (size_t)(M_CTX + b * 4096) * 512 + h * 64;
#define NA_TILE_SRC(t, kp, vp) do { if ((t) < nctx) { const size_t o_ = (size_t)((t) * 64 + srow) * cpitch + sch * 8; kp = kc_base + o_; vp = vc_base + o_; } \
                                    else { const size_t o_ = (size_t)((lo + (t) - nctx) * 64 + srow) * 512 + sch * 8; kp = kl_base + o_; vp = vl_base + o_; } } while (0)
                    u32x4 vreg;
                    { const bf16* kp; const bf16* vp; NA_TILE_SRC(0, kp, vp); if (!pre0) kreg = *(const u32x4*)kp; vreg = *(const u32x4*)vp; }
                    const int pair = wave >> 2, jb = wave & 3;
                    int rowq[2]; int rq[2];
                    if (lat) { rq[0] = r0 + 2 * pair; rq[1] = rq[0] + 1; rowq[0] = M_CTX + b * 4096 + rq[0] * 64 + 16 * jb + qc; rowq[1] = rowq[0] + 64; }
                    else { rq[0] = rq[1] = 0; rowq[0] = b * 256 + half * 128 + wave * 16 + qc; rowq[1] = rowq[0]; }
                    bf16x8 qf[2][2];
#pragma unroll
                    for (int qb = 0; qb < 2; ++qb)
#pragma unroll
                        for (int s = 0; s < 2; ++s) qf[qb][s] = *(const bf16x8*)(Qb + (size_t)rowq[qb] * 512 + h * 64 + 32 * s + 8 * g);
                    f32x4 cinv[2]; cinv[0] = (f32x4){0.f, 0.f, 0.f, 0.f}; cinv[1] = cinv[0];
                    f32x4 o[2][4], osum[2]; osum[0] = (f32x4){0.f, 0.f, 0.f, 0.f}; osum[1] = osum[0];
                    const bf16x8 ones = (bf16x8){(short)0x3F80, (short)0x3F80, (short)0x3F80, (short)0x3F80, (short)0x3F80, (short)0x3F80, (short)0x3F80, (short)0x3F80};
#pragma unroll
                    for (int qb = 0; qb < 2; ++qb)
#pragma unroll
                        for (int c = 0; c < 4; ++c) o[qb][c] = (f32x4){0.f, 0.f, 0.f, 0.f};
                    if (lat && h != h_tab) { h_tab = h; const float* rb = INP(I_RELB) + (size_t)(l * 8 + h) * 465;
                        for (int i = tid; i < 15 * 64; i += 512) { const int dr = i >> 6, x = (i & 63) - 16; btab[i] = (x >= 0 && x < 31) ? rb[dr * 31 + x] * LOG2E : 0.f; } }
                    *(LAS u32x4*)(nl + sdst) = kreg; *(LAS u32x4*)(nl + 8192 + sdst) = vreg;
                    if (1 < ntile) { const bf16* kp; const bf16* vp; NA_TILE_SRC(1, kp, vp); kreg = *(const u32x4*)kp; vreg = *(const u32x4*)vp; }
                    __syncthreads();
                    const int cq = 16 * jb + qc, cs0 = min(max(cq - 8, 0), 48), st = min(max(16 * jb - 8, 0), 32);
                    f32x4 maskc[2];
#pragma unroll
                    for (int tt = 0; tt < 2; ++tt)
#pragma unroll
                        for (int i = 0; i < 4; ++i) { const int kc = st + 16 * tt + 4 * g + i; maskc[tt][i] = ((kc >= cs0) && (kc < cs0 + 16)) ? 0.f : -INFINITY; }
                    f32x4 mk[2][2]; mk[0][0] = maskc[0]; mk[0][1] = maskc[1]; mk[1][0] = maskc[0]; mk[1][1] = maskc[1];
                    auto na_tiles = [&](auto latc_) __attribute__((always_inline)) {
                    constexpr bool LT = decltype(latc_)::value;
                    for (int t = 0; t < nctx; ++t) {
                        LAS unsigned char* kb = nl + (t & 1) * 16384; LAS unsigned char* vb = kb + 8192;
                        {
                            bf16x8 pf1d, vfd[4];
#pragma unroll
                            for (int ks = 0; ks < 2; ++ks) {
                                bf16x8 kf[2][2], vf[4];
#pragma unroll
                                for (int kt = 0; kt < 2; ++kt) na_kfrag(kb, 32 * ks + 16 * kt, lane, kf[kt][0], kf[kt][1]);
#pragma unroll
                                for (int c = 0; c < 4; ++c) vf[c] = na_vfrag(vb, 32 * ks, 32 * ks + 16, lane, c);
                                f32x4 s0[2], s1[2];
                                {   const f32x4 c0 = cinv[0], c1 = cinv[1];
#pragma unroll
                                    for (int kt = 0; kt < 2; ++kt) {
                                        s0[kt] = na_qk2(kf[kt][0], kf[kt][1], qf[0][0], qf[0][1], c0);
                                        if (LT) s1[kt] = na_qk2(kf[kt][0], kf[kt][1], qf[1][0], qf[1][1], c1); } }
                                if (!LT) {
                                    bf16x8 pf0[1]; float dl;
                                    na_sm<2>(s0, cinv[0], mk[0], t == 0 && ks == 0, o[0], osum[0], pf0, dl);
#pragma unroll
                                    for (int c = 0; c < 4; ++c) o[0][c] = __builtin_amdgcn_mfma_f32_16x16x32_bf16(vf[c], pf0[0], o[0][c], 0, 0, 0);
                                    osum[0] = __builtin_amdgcn_mfma_f32_16x16x32_bf16(ones, pf0[0], osum[0], 0, 0, 0);
                                } else {
                                    na_sm_pre2(s0, cinv[0], mk[0], t == 0 && ks == 0, o[0], osum[0]);
                                    bf16x8 pf0;
                                    if (ks == 0) {
                                        na_sm_pre2(s1, cinv[1], mk[1], t == 0 && ks == 0, o[1], osum[1]);
#pragma unroll
                                        for (int tt = 0; tt < 2; ++tt)
#pragma unroll
                                            for (int i = 0; i < 4; ++i) s0[tt][i] = __builtin_amdgcn_exp2f(s0[tt][i]);
                                        pf0 = na_pack2(s0);
                                    } else {
                                        __builtin_amdgcn_sched_barrier(0);
#pragma unroll
                                        for (int c = 0; c < 4; ++c) {
                                            o[1][c] = __builtin_amdgcn_mfma_f32_16x16x32_bf16(vfd[c], pf1d, o[1][c], 0, 0, 0);
                                            s0[c >> 1][2 * (c & 1)] = __builtin_amdgcn_exp2f(s0[c >> 1][2 * (c & 1)]); s0[c >> 1][2 * (c & 1) + 1] = __builtin_amdgcn_exp2f(s0[c >> 1][2 * (c & 1) + 1]);
                                            __builtin_amdgcn_sched_barrier(0);
                                        }
                                        osum[1] = __builtin_amdgcn_mfma_f32_16x16x32_bf16(ones, pf1d, osum[1], 0, 0, 0);
                                        pf0 = na_pack2(s0);
                                        __builtin_amdgcn_sched_barrier(0);
                                        na_sm_pre2(s1, cinv[1], mk[1], false, o[1], osum[1]);
                                    }
                                    __builtin_amdgcn_sched_barrier(0);
#pragma unroll
                                    for (int c = 0; c < 4; ++c) {
                                        o[0][c] = __builtin_amdgcn_mfma_f32_16x16x32_bf16(vf[c], pf0, o[0][c], 0, 0, 0);
                                        s1[c >> 1][2 * (c & 1)] = __builtin_amdgcn_exp2f(s1[c >> 1][2 * (c & 1)]); s1[c >> 1][2 * (c & 1) + 1] = __builtin_amdgcn_exp2f(s1[c >> 1][2 * (c & 1) + 1]);
                                        __builtin_amdgcn_sched_barrier(0);
                                    }
                                    osum[0] = __builtin_amdgcn_mfma_f32_16x16x32_bf16(ones, pf0, osum[0], 0, 0, 0);
                                    const bf16x8 pf1 = na_pack2(s1);
                                    __builtin_amdgcn_sched_barrier(0);
                                    if (ks == 0) { pf1d = pf1;
#pragma unroll
                                        for (int c = 0; c < 4; ++c) vfd[c] = vf[c];
                                    } else {
#pragma unroll
                                        for (int c = 0; c < 4; ++c) o[1][c] = __builtin_amdgcn_mfma_f32_16x16x32_bf16(vf[c], pf1, o[1][c], 0, 0, 0);
                                        osum[1] = __builtin_amdgcn_mfma_f32_16x16x32_bf16(ones, pf1, osum[1], 0, 0, 0);
                                    }
                                }
                            }
                        }
                        if (t + 1 < ntile) { LAS unsigned char* kn = nl + ((t + 1) & 1) * 16384; *(LAS u32x4*)(kn + sdst) = kreg; *(LAS u32x4*)(kn + 8192 + sdst) = vreg; }
                        if (t + 2 < ntile) { const bf16* kp; const bf16* vp; NA_TILE_SRC(t + 2, kp, vp); kreg = *(const u32x4*)kp; vreg = *(const u32x4*)vp; }
                        __syncthreads();
                    }
                    if (LT) for (int t = nctx; t < ntile; ++t) {
                        LAS unsigned char* kb = nl + (t & 1) * 16384; LAS unsigned char* vb = kb + 8192;
                        {
                            const int kr = lo + t - nctx;
                            const int rsA = min(max(rq[0] - 4, 0), 56), rsB = min(max(rq[1] - 4, 0), 56);
                            const bool actA = kr >= rsA && kr < rsA + 8, actB = kr >= rsB && kr < rsB + 8;
                            if (actA || actB) {
                                bf16x8 kf[2][2], vf[4];
#pragma unroll
                                for (int kt = 0; kt < 2; ++kt) na_kfrag(kb, st + 16 * kt, lane, kf[kt][0], kf[kt][1]);
#pragma unroll
                                for (int c = 0; c < 4; ++c) vf[c] = na_vfrag(vb, st, st + 16, lane, c);
#pragma unroll
                                for (int qb = 0; qb < 2; ++qb) {
                                    if (qb == 0 ? actA : actB) {
                                        const LAS float* brow = btab + (kr - rq[qb] + 7) * 64 + (31 - cq) + st + 4 * g;
                                        f32x4 bz[2];
#pragma unroll
                                        for (int tt = 0; tt < 2; ++tt)
#pragma unroll
                                            for (int i = 0; i < 4; ++i) bz[tt][i] = brow[16 * tt + i];
                                        f32x4 sx[2];
#pragma unroll
                                        for (int tt = 0; tt < 2; ++tt) sx[tt] = na_qk2(kf[tt][0], kf[tt][1], qf[qb][0], qf[qb][1], mk[qb][tt] + bz[tt]);
                                        bf16x8 pf[1]; float dl;
                                        na_sm<2>(sx, cinv[qb], mk[qb], false, o[qb], osum[qb], pf, dl);
#pragma unroll
                                        for (int c = 0; c < 4; ++c) o[qb][c] = __builtin_amdgcn_mfma_f32_16x16x32_bf16(vf[c], pf[0], o[qb][c], 0, 0, 0);
                                        osum[qb] = __builtin_amdgcn_mfma_f32_16x16x32_bf16(ones, pf[0], osum[qb], 0, 0, 0);
                                    }
                                }
                            }
                        }
                        if (t + 1 < ntile) { LAS unsigned char* kn = nl + ((t + 1) & 1) * 16384; *(LAS u32x4*)(kn + sdst) = kreg; *(LAS u32x4*)(kn + 8192 + sdst) = vreg; }
                        if (t + 2 < ntile) { const bf16* kp; const bf16* vp; NA_TILE_SRC(t + 2, kp, vp); kreg = *(const u32x4*)kp; vreg = *(const u32x4*)vp; }
                        __syncthreads();
                    }
                    };
                    if (lat) na_tiles(std::true_type{}); else na_tiles(std::false_type{});
                    {
                        const int it2 = it + G; pre0 = it2 < 1280;
                        if (pre0) { const bf16* kb2; const bf16* vb2; int cp2;
                            if (it2 < 1024) { const int b2 = it2 >> 7, h2 = (it2 >> 4) & 7; kb2 = CKb + (size_t)((b2 * 2 + l) * 8 + h2) * 512 * 64; vb2 = CVb + (size_t)((b2 * 2 + l) * 8 + h2) * 512 * 64; cp2 = 64; }
                            else { const int u2 = it2 - 1024, b2 = u2 >> 4, h2 = (u2 >> 1) & 7; kb2 = Kb + (size_t)(b2 * 256) * 512 + h2 * 64; vb2 = Vb + (size_t)(b2 * 256) * 512 + h2 * 64; cp2 = 512; }
                            const size_t o2 = (size_t)srow * cp2 + sch * 8; kreg = *(const u32x4*)(kb2 + o2); (void)vb2; } }
#pragma unroll
                    for (int qb = 0; qb < 2; ++qb) {
                        if (qb == 0 || lat) {
                            const float inv = 1.0f / osum[qb][0];
                            bf16* yo = Y + (size_t)rowq[qb] * DM + 256 + h * 64 + 4 * g;
#pragma unroll
                            for (int c = 0; c < 4; ++c) { u32x2 w; w.x = cvt_pk_bf16(o[qb][c][0] * inv, o[qb][c][1] * inv); w.y = cvt_pk_bf16(o[qb][c][2] * inv, o[qb][c][3] * inv); *(u32x2*)(yo + 16 * c) = w; }
                        }
                    }
                    __syncthreads();
#undef NA_TILE_SRC
                }
                __builtin_amdgcn_s_setprio(0);
            }
#endif
        }
        SPLIT_WAIT(P + 2);
        for (int rep_ = 1 + ((REPEAT_MASK >> 5) & 1); rep_ > 0 && IN_PH(P + 3); --rep_) { WSL
#if GLA_NAIVE
            const float* gg = INP(I_GLAG) + l * 64;
            for (int it = bid; it < NCHUNK * 4; it += G) {
                const int cidx = it >> 2, h = it & 3, row0 = cidx * 64;
                GLA_PREP(cidx, h);
                for (int idx = tid; idx < 2048; idx += 512) { g_sf[idx] = SINF[(size_t)it * 2048 + idx]; g_sb[idx] = SINB[(size_t)it * 2048 + idx]; }
                for (int idx = tid; idx < 4096; idx += 512) { const int t = idx >> 6, s = idx & 63; float a = 0.f;
                    if (s <= t) {
#pragma unroll
                        for (int d = 0; d < 32; ++d) a += g_qf[t * 33 + d] * g_kf[s * 33 + d]; }
                    if (s >= t) {
#pragma unroll
                        for (int d = 0; d < 32; ++d) a += g_qb[t * 33 + d] * g_kb[s * 33 + d]; }
                    g_A[t * 65 + s] = a; }
                __syncthreads();
                {   const int t = tid >> 3, dv0 = (tid & 7) * 8;
                    float acc[8];
#pragma unroll
                    for (int j = 0; j < 8; ++j) acc[j] = 0.f;
                    for (int d = 0; d < 32; ++d) { const float a1 = g_qf[t * 33 + d], a2 = g_qb[t * 33 + d];
#pragma unroll
                        for (int j = 0; j < 8; ++j) acc[j] += a1 * g_sf[d * 64 + dv0 + j] + a2 * g_sb[d * 64 + dv0 + j]; }
                    for (int s = 0; s < 64; ++s) { const float a = g_A[t * 65 + s];
#pragma unroll
                        for (int j = 0; j < 8; ++j) acc[j] += a * g_v[s * 64 + dv0 + j]; }
                    float ss = 0.f;
#pragma unroll
                    for (int j = 0; j < 8; ++j) ss += acc[j] * acc[j];
                    ss += __shfl_xor(ss, 1); ss += __shfl_xor(ss, 2); ss += __shfl_xor(ss, 4);
                    const float rn = rsqrtf(ss * (1.0f / 64.0f) + EPS);
                    const u32x4 gsw = *(const u32x4*)(GS + (size_t)(row0 + t) * 256 + h * 64 + dv0);
                    float o[8];
                    o[0] = acc[0] * rn * gg[dv0 + 0] * bflo(gsw.x); o[1] = acc[1] * rn * gg[dv0 + 1] * bfhi(gsw.x);
                    o[2] = acc[2] * rn * gg[dv0 + 2] * bflo(gsw.y); o[3] = acc[3] * rn * gg[dv0 + 3] * bfhi(gsw.y);
                    o[4] = acc[4] * rn * gg[dv0 + 4] * bflo(gsw.z); o[5] = acc[5] * rn * gg[dv0 + 5] * bfhi(gsw.z);
                    o[6] = acc[6] * rn * gg[dv0 + 6] * bflo(gsw.w); o[7] = acc[7] * rn * gg[dv0 + 7] * bfhi(gsw.w);
                    u32x4 w; w.x = cvt_pk_bf16(o[0], o[1]); w.y = cvt_pk_bf16(o[2], o[3]); w.z = cvt_pk_bf16(o[4], o[5]); w.w = cvt_pk_bf16(o[6], o[7]);
                    *(u32x4*)(Y + (size_t)(row0 + t) * DM + 768 + h * 64 + dv0) = w;
                }
                __syncthreads();
            }
#else
            {
                const float* gg = INP(I_GLAG) + l * 64;
                const int h = wave & 3, th = wave >> 2;
                LAS unsigned char* qfi = lds + (0 * 4 + h) * 4096; LAS unsigned char* kfi = lds + (1 * 4 + h) * 4096;
                LAS unsigned char* qbi = lds + (2 * 4 + h) * 4096; LAS unsigned char* kbi = lds + (3 * 4 + h) * 4096;
                LAS unsigned char* vimg = lds + 65536 + h * 8192;
                const int tid_g3 = tid;
                for (int cidx = (bid + G - G / 4) % G; cidx < NCHUNK; cidx += G) {
                    int tid = tid_g3; asm volatile("" : "+v"(tid)); const int lane = tid & 63, g = lane >> 4;
                    const int row0 = cidx * 64;
                    u32x2 gsv[2][4]; f32x4 gnv[4];
#pragma unroll
                    for (int dvt = 0; dvt < 4; ++dvt) { gnv[dvt] = *(const f32x4*)(gg + 16 * dvt + 4 * g);
#pragma unroll
                        for (int ttl = 0; ttl < 2; ++ttl) gsv[ttl][dvt] = *(const u32x2*)(GS + (size_t)(row0 + 16 * (2 * th + ttl) + (lane & 15)) * 256 + h * 64 + 16 * dvt + 4 * g); }
                    {   const int t = tid >> 3, part = tid & 7;
                        const u32x4* sp = (const u32x4*)(QKT + (size_t)(row0 + t) * 512 + part * 64);
#pragma unroll
                        for (int c8 = 0; c8 < 8; ++c8) { const int cc = part * 8 + c8, a = ((cc >> 5) * 2 + ((cc >> 4) & 1)) * 4 + ((cc >> 2) & 3);
                            *(LAS u32x4*)(lds + a * 4096 + off64(t, cc & 3)) = sp[c8]; }
                        const u32x4* vp = (const u32x4*)(VL + (size_t)(row0 + t) * 256 + part * 32);
#pragma unroll
                        for (int c4 = 0; c4 < 4; ++c4) *(LAS u32x4*)(lds + 65536 + (part >> 1) * 8192 + na_off(t, (part & 1) * 4 + c4)) = vp[c4];
#pragma unroll
                        for (int k4 = 0; k4 < 4; ++k4) { const int idx = tid + 512 * k4, img = idx >> 8, c = idx & 255;
                            const bf16* sp2 = ((img >> 2) ? STB : STF) + ((size_t)cidx * 4 + (img & 3)) * 2048 + c * 8;
                            *(LAS u32x4*)(lds + 98304 + img * 4096 + na_off(c >> 3, c & 7)) = *(const u32x4*)sp2; }
                    }
                    __syncthreads();
#pragma unroll
                    for (int ttl = 0; ttl < 2; ++ttl) {
                        const int tt = 2 * th + ttl, trow = 16 * tt + (lane & 15);
                        const bf16x8 qff = *(const LAS bf16x8*)(qfi + off64(trow, g)), qbf = *(const LAS bf16x8*)(qbi + off64(trow, g));
                        f32x4 at[4];
#pragma unroll
                        for (int st = 0; st < 4; ++st) {
                            const int srow = 16 * st + (lane & 15);
                            const bf16x8 kf = *(const LAS bf16x8*)(kfi + off64(srow, g)), kb = *(const LAS bf16x8*)(kbi + off64(srow, g));
                            const f32x4 z = (f32x4){0.f, 0.f, 0.f, 0.f};
                            const f32x4 df = __builtin_amdgcn_mfma_f32_16x16x32_bf16(kf, qff, z, 0, 0, 0);
                            const f32x4 db = __builtin_amdgcn_mfma_f32_16x16x32_bf16(kb, qbf, z, 0, 0, 0);
#pragma unroll
                            for (int i = 0; i < 4; ++i) { const int sg = 16 * st + 4 * g + i; at[st][i] = (sg <= trow ? df[i] : 0.f) + (sg >= trow ? db[i] : 0.f); }
                        }
                        const bf16x8 pf0 = __builtin_bit_cast(bf16x8, (u32x4){cvt_pk_bf16(at[0][0], at[0][1]), cvt_pk_bf16(at[0][2], at[0][3]), cvt_pk_bf16(at[1][0], at[1][1]), cvt_pk_bf16(at[1][2], at[1][3])});
                        const bf16x8 pf1 = __builtin_bit_cast(bf16x8, (u32x4){cvt_pk_bf16(at[2][0], at[2][1]), cvt_pk_bf16(at[2][2], at[2][3]), cvt_pk_bf16(at[3][0], at[3][1]), cvt_pk_bf16(at[3][2], at[3][3])});
                        f32x4 o[4];
#pragma unroll
                        for (int c = 0; c < 4; ++c) o[c] = (f32x4){0.f, 0.f, 0.f, 0.f};
                        na_pv(vimg, 0, 16, lane, pf0, o);
                        na_pv(vimg, 32, 48, lane, pf1, o);
                        {   const int q4 = (lane & 15) >> 2, p4 = lane & 3;
                            LAS unsigned char* sfi = lds + 98304 + h * 4096; LAS unsigned char* sbi = sfi + 16384;
#pragma unroll
                            for (int dvt = 0; dvt < 4; ++dvt) {
                                const int o0 = na_off(8 * g + q4, 2 * dvt + (p4 >> 1)) + 8 * (p4 & 1), o1 = na_off(8 * g + 4 + q4, 2 * dvt + (p4 >> 1)) + 8 * (p4 & 1);
                                const s16x4 f0 = na_tr(sfi + o0), f1 = na_tr(sfi + o1), b0 = na_tr(sbi + o0), b1 = na_tr(sbi + o1);
                                const bf16x8 sf = (bf16x8){f0[0], f0[1], f0[2], f0[3], f1[0], f1[1], f1[2], f1[3]}, sb = (bf16x8){b0[0], b0[1], b0[2], b0[3], b1[0], b1[1], b1[2], b1[3]};
                                o[dvt] = __builtin_amdgcn_mfma_f32_16x16x32_bf16(sf, qff, o[dvt], 0, 0, 0);
                                o[dvt] = __builtin_amdgcn_mfma_f32_16x16x32_bf16(sb, qbf, o[dvt], 0, 0, 0);
                            } }
                        float ss = 0.f;
#pragma unroll
                        for (int dvt = 0; dvt < 4; ++dvt) ss += (o[dvt][0] * o[dvt][0] + o[dvt][1] * o[dvt][1]) + (o[dvt][2] * o[dvt][2] + o[dvt][3] * o[dvt][3]);
                        ss += __shfl_xor(ss, 16); ss += __shfl_xor(ss, 32);
                        const float rn = rsqrtf(ss * (1.0f / 64.0f) + EPS);
                        const size_t row = (size_t)(row0 + trow);
#pragma unroll
                        for (int dvt = 0; dvt < 4; ++dvt) {
                            const int dv = 16 * dvt + 4 * g;
                            const f32x4 gn = gnv[dvt];
                            const u32x2 gsw = gsv[ttl][dvt];
                            u32x2 w; w.x = cvt_pk_bf16(o[dvt][0] * rn * gn[0] * bflo(gsw.x), o[dvt][1] * rn * gn[1] * bfhi(gsw.x));
                            w.y = cvt_pk_bf16(o[dvt][2] * rn * gn[2] * bflo(gsw.y), o[dvt][3] * rn * gn[3] * bfhi(gsw.y));
                            *(u32x2*)(Y + row * DM + 768 + h * 64 + dv) = w;
                        }
                    }
                    __syncthreads();
                }
            }
#endif
        }
        SEAM(P + 3);
        for (int rep_ = 1 + ((REPEAT_MASK >> 6) & 1); rep_ > 0 && IN_PH(P + 4); --rep_) { WSL
            pg8::Gemm g{Y, Wout_t + (size_t)l * DM * DM, M, DM, DM}; pg8::StaticOrder S; S.init(M, DM, G, bid, 1);
            EpiRes E{wsl, INP(I_XP), INP(I_XS), (l == 0) ? (const bf16*)nullptr : (const bf16*)outl, outl, XR, l * NCOND * 6144 + 2 * 1024, (l * 2 + 1) * NCOND * DM, rep_ == 2 ? 5 * M : (2 * l + 1) * M, rep_ == 2};
            pg8::gemm_phase<EpiRes, pg8::StaticOrder>(lds, g, S, E, tid);
            { pg8::Unit su; if (S.sub4(0, su)) { int t2_ = tid; asm volatile("" : "+v"(t2_)); pg8::gemm_sub4<EpiRes>(lds, g, su, E, t2_); } }
        }
        SEAM(P + 4);
        for (int rep_ = 1 + ((REPEAT_MASK >> 7) & 1); rep_ > 0 && IN_PH(P + 5); --rep_) { WSL
            pg8::Gemm g{XA, Wffi_t + (size_t)l * FF2 * DM, M, FF2, DM}; pg8::StaticOrder S; S.init(M, FF2, G, bid, 0);
            EpiD E{wsl, l};
            pg8::gemm_phase<EpiD, pg8::StaticOrder>(lds, g, S, E, tid);
            _Pragma("unroll 1") for (int k2_ = 0; k2_ < 2; ++k2_) { pg8::Unit su; if (!S.sub4(k2_, su)) break; int t2_ = tid; asm volatile("" : "+v"(t2_)); pg8::gemm_sub4<EpiD>(lds, g, su, E, t2_); }
        }
        SEAM(P + 5);
        for (int rep_ = 1 + ((REPEAT_MASK >> 8) & 1); rep_ > 0 && IN_PH(P + 6); --rep_) { WSL
            pg8::Gemm g{H, Wffo_t + (size_t)l * DM * DFF, M, DM, DFF}; pg8::StaticOrder S; S.init(M, DM, G, bid, 1);
            const bool more = (l + 1 < DEPTH);
            EpiRes E{wsl, nullptr, nullptr, XR, outl, more ? (bf16*)outl : (bf16*)nullptr, l * NCOND * 6144 + 5 * 1024, more ? ((l + 1) * 2 + 0) * NCOND * DM : -1, rep_ == 2 ? 5 * M : (2 * (l + 1)) * M, rep_ == 2};
            pg8::gemm_phase<EpiRes, pg8::StaticOrder>(lds, g, S, E, tid);
            { pg8::Unit su; if (S.sub4(0, su)) { int t2_ = tid; asm volatile("" : "+v"(t2_)); pg8::gemm_sub4<EpiRes>(lds, g, su, E, t2_); } }
        }
        SEAM(P + 6);
    }
#undef IN_PH
#undef SEAM
#undef GLA_PREP
}

extern "C" void kernel_launch(void* const* d_in, const int* in_sizes, int n_in, void* d_out, int out_size, void* d_ws, size_t ws_size, hipStream_t stream) {
    static int grid = 0;
    if (grid == 0) {
        if (n_in != 26 || ws_size < WS_END) { fprintf(stderr, "kernel_launch: unexpected n_in %d / ws %zu\n", n_in, ws_size); grid = -1; return; }
        int dev = 0, cus = 0, per_cu = 0;
        if (hipGetDevice(&dev) != hipSuccess || hipDeviceGetAttribute(&cus, hipDeviceAttributeMultiprocessorCount, dev) != hipSuccess) { grid = -1; return; }
        if (hipFuncSetAttribute((const void*)fwd_kernel, hipFuncAttributeMaxDynamicSharedMemorySize, LDS_BYTES) != hipSuccess) { fprintf(stderr, "kernel_launch: hipFuncSetAttribute failed\n"); grid = -1; return; }
        if (hipOccupancyMaxActiveBlocksPerMultiprocessor(&per_cu, (const void*)fwd_kernel, 512, LDS_BYTES) != hipSuccess || per_cu < 1) { fprintf(stderr, "kernel_launch: occupancy query says %d\n", per_cu); (void)hipGetLastError(); grid = -1; return; }
        grid = cus;
    }
    if (grid < 0) return;
    (void)hipMemsetAsync((char*)d_ws, 0, ZERO_BYTES, stream);
    Args a{};
    for (int i = 0; i < 26; ++i) a.in[i] = (const float*)d_in[i];
    a.out = (float*)d_out; a.ws = (unsigned char*)d_ws;
#if MK_ONE_LAUNCH
    a.ph_lo = 0; a.ph_hi = NPHASE;
    void* kargs[] = {&a};
    hipError_t e = hipLaunchCooperativeKernel((const void*)fwd_kernel, dim3(grid), dim3(512), kargs, LDS_BYTES, stream);
    if (e != hipSuccess) fprintf(stderr, "kernel_launch: cooperative launch failed: %s\n", hipGetErrorString(e));
#else
    for (int p = 0; p < NPHASE; ++p) { a.ph_lo = p; a.ph_hi = p + 1; hipLaunchKernelGGL(fwd_kernel, dim3(grid), dim3(512), LDS_BYTES, stream, a); }
#endif
}
```
